# Optimizing an MI355X kernel written in HIP

```python
import jax, jax.numpy as jnp
from jax import lax
import numpy as np

D_MODEL = 1024
BATCH = 2
SEQ = 8192
DEPTH = 1
DEC_BATCH = 8
DEC_SEQ = 32
PAST_LEN = 2048

CHUNK = 64
A_HEADS = 8
A_DK = 128
A_DV = 128
A_WIDTH = A_HEADS * A_DK
POOL_WINDOWS = (2, 4, 8, 16)
POOL_GROUPS = 4
POOL_GDIM = 128
B_WIDTH = POOL_GROUPS * POOL_GDIM
POOL_BUF = max(POOL_WINDOWS) - 1
D_FF = 2816
PLE_DIM = 256
IN_WIDTH = 4 * A_WIDTH + B_WIDTH + 2 * D_MODEL
IN_SPLITS = (A_WIDTH, 2 * A_WIDTH, 3 * A_WIDTH, 4 * A_WIDTH,
             4 * A_WIDTH + B_WIDTH, 4 * A_WIDTH + B_WIDTH + D_MODEL)
N_NORMS = 8
EPS = 1e-6

kernel_name = 'hgrn2_pool_macaron_streaming_step'


def rmsnorm(x, g):
    xf = x.astype(jnp.float32)
    y = xf * lax.rsqrt(jnp.mean(xf * xf, axis=-1, keepdims=True) + EPS)
    return (y * g.astype(jnp.float32)).astype(x.dtype)


def swiglu(h, w_gu, w_down):
    a, b = jnp.split(h @ w_gu, 2, axis=-1)
    return (jax.nn.silu(a) * b) @ w_down


def hgrn_chunked(q, k, v, logf, s0, chunk):
    bsz, t_len, n_h, _ = q.shape
    n_c = t_len // chunk

    def to_chunks(a):
        return a.reshape(bsz, n_c, chunk, n_h, a.shape[-1]).transpose(1, 0, 3, 2, 4)

    mask = jnp.tril(jnp.ones((chunk, chunk), dtype=bool))[:, :, None]

    def step(S, inp):
        qc, kc, vc, gc = inp
        G = jnp.cumsum(gc, axis=-2)
        o_inter = jnp.einsum('bhtk,bhkv->bhtv', qc * jnp.exp(G), S)
        diff = G[:, :, :, None, :] - G[:, :, None, :, :]
        decay = jnp.exp(jnp.where(mask, diff, -jnp.inf))
        att = jnp.einsum('bhtk,bhsk,bhtsk->bhts', qc, kc, decay)
        o = o_inter + jnp.einsum('bhts,bhsv->bhtv', att, vc)
        G_last = G[:, :, -1:, :]
        S_new = (jnp.exp(G_last[:, :, 0, :])[..., None] * S
                 + jnp.einsum('bhsk,bhsv->bhkv', kc * jnp.exp(G_last - G), vc))
        return S_new, o

    S, o = lax.scan(step, s0, (to_chunks(q), to_chunks(k), to_chunks(v), to_chunks(logf)))
    o = o.transpose(1, 0, 3, 2, 4).reshape(bsz, t_len, n_h, v.shape[-1])
    return o, S


def pool_mix(u, buf, start_pos, w_pool, scale):
    bsz, t_len, width = u.shape
    uf = u.astype(jnp.float32)
    xp = jnp.concatenate([buf.astype(jnp.float32), uf], axis=1)
    c = jnp.cumsum(jnp.pad(xp, ((0, 0), (1, 0), (0, 0))), axis=1)
    end = c[:, POOL_BUF + 1:]
    pos = start_pos + jnp.arange(t_len)
    groups = []
    for g, w in enumerate(POOL_WINDOWS):
        sl = slice(g * POOL_GDIM, (g + 1) * POOL_GDIM)
        start = c[:, POOL_BUF + 1 - w: POOL_BUF + 1 - w + t_len, sl]
        cnt = jnp.minimum(w, pos + 1).astype(jnp.float32)[None, :, None]
        groups.append((end[..., sl] - start) / cnt - uf[..., sl])
    pooled = jnp.stack(groups, axis=2)
    mixed = jnp.einsum('btgc,gcd->btgd', pooled, w_pool.astype(jnp.float32))
    mixed = mixed.reshape(bsz, t_len, width) * scale.astype(jnp.float32)
    return mixed.astype(u.dtype), xp[:, -POOL_BUF:].astype(u.dtype)


def layer(x, p, s_hgrn, s_pool, start_pos, chunk, lb, gains,
          w_ffn1_gu, w_ffn1_down, w_in, a_gnorm, w_a_up, w_pool, pool_scale,
          w_b_up, w_out, w_ffn2_gu, w_ffn2_down, w_ple_proj, w_ple_gate):
    bsz, t_len, _ = x.shape
    x = x + 0.5 * rmsnorm(swiglu(rmsnorm(x, gains[0]), w_ffn1_gu, w_ffn1_down), gains[1])
    h = rmsnorm(x, gains[2])
    z = h @ w_in
    q, fz, iv, og, u, ga, gb = jnp.split(z, IN_SPLITS, axis=-1)
    lb_h = lb.reshape(A_HEADS, A_DK)
    fz = fz.astype(jnp.float32).reshape(bsz, t_len, A_HEADS, A_DK)
    logf = jnp.logaddexp(jnp.log(lb_h), jnp.log1p(-lb_h) + jax.nn.log_sigmoid(fz))
    k = (1.0 - lb_h) * jax.nn.sigmoid(-fz)
    qh = jax.nn.silu(q.astype(jnp.float32)).reshape(bsz, t_len, A_HEADS, A_DK)
    vh = iv.astype(jnp.float32).reshape(bsz, t_len, A_HEADS, A_DV)
    o, s_new = hgrn_chunked(qh, k, vh, logf, s_hgrn.astype(jnp.float32), chunk)
    o = o * lax.rsqrt(jnp.mean(o * o, axis=-1, keepdims=True) + EPS) * a_gnorm.astype(jnp.float32)
    o = o.reshape(bsz, t_len, A_WIDTH).astype(x.dtype) * jax.nn.silu(og)
    y_a = o @ w_a_up
    pooled, buf_new = pool_mix(u, s_pool, start_pos, w_pool, pool_scale)
    y_b = pooled @ w_b_up
    m = jax.nn.sigmoid(ga) * y_a + jax.nn.sigmoid(gb) * y_b
    x = x + rmsnorm(m @ w_out, gains[3])
    x = x + 0.5 * rmsnorm(swiglu(rmsnorm(x, gains[4]), w_ffn2_gu, w_ffn2_down), gains[5])
    e = p.astype(x.dtype) @ w_ple_proj
    gate = jax.nn.sigmoid(rmsnorm(x, gains[6]) @ w_ple_gate)
    x = x + rmsnorm(gate * e, gains[7])
    return x, s_new, buf_new


def setup_inputs(seed: int = 0) -> dict:
    key = jax.random.key(seed)
    ks = jax.random.split(key, 24)

    def nrm(k, shape, scale):
        return jax.random.normal(k, shape, jnp.float32) * scale

    return {
        'x_prompt': nrm(ks[0], (BATCH, SEQ, D_MODEL), 1.0),
        'x_sample': nrm(ks[1], (DEC_BATCH, DEC_SEQ, D_MODEL), 1.0),
        'p_prompt': nrm(ks[2], (DEPTH, BATCH, SEQ, PLE_DIM), 1.0),
        'p_sample': nrm(ks[3], (DEPTH, DEC_BATCH, DEC_SEQ, PLE_DIM), 1.0),
        'state_hgrn': nrm(ks[4], (DEPTH, DEC_BATCH, A_HEADS, A_DK, A_DV), 0.5),
        'state_pool': nrm(ks[5], (DEPTH, DEC_BATCH, POOL_BUF, B_WIDTH), 1.0),
        'norm_gains': 1.0 + nrm(ks[6], (DEPTH, N_NORMS, D_MODEL), 0.02),
        'lb_logits': nrm(ks[7], (DEPTH + 1, A_WIDTH), 0.1),
        'w_ffn1_gu': nrm(ks[8], (DEPTH, D_MODEL, 2 * D_FF), D_MODEL ** -0.5),
        'w_ffn1_down': nrm(ks[9], (DEPTH, D_FF, D_MODEL), D_FF ** -0.5),
        'w_in': nrm(ks[10], (DEPTH, D_MODEL, IN_WIDTH), D_MODEL ** -0.5),
        'a_gnorm': 1.0 + nrm(ks[11], (DEPTH, A_DV), 0.02),
        'w_a_up': nrm(ks[12], (DEPTH, A_WIDTH, D_MODEL), A_WIDTH ** -0.5),
        'w_pool': nrm(ks[13], (DEPTH, POOL_GROUPS, POOL_GDIM, POOL_GDIM), POOL_GDIM ** -0.5),
        'pool_scale': 1.0 + nrm(ks[14], (DEPTH, B_WIDTH), 0.1),
        'w_b_up': nrm(ks[15], (DEPTH, B_WIDTH, D_MODEL), B_WIDTH ** -0.5),
        'w_out': nrm(ks[16], (DEPTH, D_MODEL, D_MODEL), D_MODEL ** -0.5),
        'w_ffn2_gu': nrm(ks[17], (DEPTH, D_MODEL, 2 * D_FF), D_MODEL ** -0.5),
        'w_ffn2_down': nrm(ks[18], (DEPTH, D_FF, D_MODEL), D_FF ** -0.5),
        'w_ple_proj': nrm(ks[19], (DEPTH, PLE_DIM, D_MODEL), PLE_DIM ** -0.5),
        'w_ple_gate': nrm(ks[20], (DEPTH, D_MODEL, D_MODEL), D_MODEL ** -0.5),
    }


def reference(x_prompt, x_sample, p_prompt, p_sample, state_hgrn, state_pool,
              norm_gains, lb_logits, w_ffn1_gu, w_ffn1_down, w_in, a_gnorm, w_a_up,
              w_pool, pool_scale, w_b_up, w_out, w_ffn2_gu, w_ffn2_down,
              w_ple_proj, w_ple_gate):
    lb_all = jnp.cumsum(jax.nn.softmax(lb_logits.astype(jnp.float32), axis=0), axis=0)
    bsz_p = x_prompt.shape[0]
    dec_len = x_sample.shape[1]
    xp, xs = x_prompt, x_sample
    hp_list, bp_list, hs_list, bs_list = [], [], [], []
    for l in range(DEPTH):
        weights = (w_ffn1_gu[l], w_ffn1_down[l], w_in[l], a_gnorm[l], w_a_up[l], w_pool[l],
                   pool_scale[l], w_b_up[l], w_out[l], w_ffn2_gu[l], w_ffn2_down[l],
                   w_ple_proj[l], w_ple_gate[l])
        s0 = jnp.zeros((bsz_p, A_HEADS, A_DK, A_DV), jnp.float32)
        b0 = jnp.zeros((bsz_p, POOL_BUF, B_WIDTH), xp.dtype)
        xp, hp, bp = layer(xp, p_prompt[l], s0, b0, 0, CHUNK, lb_all[l], norm_gains[l], *weights)
        xs, hs, bs = layer(xs, p_sample[l], state_hgrn[l], state_pool[l], PAST_LEN, dec_len,
                           lb_all[l], norm_gains[l], *weights)
        hp_list.append(hp)
        bp_list.append(bp)
        hs_list.append(hs)
        bs_list.append(bs)
    new_hgrn_prompt = jnp.stack(hp_list)
    new_pool_prompt = jnp.stack(bp_list)
    new_hgrn_sample = jnp.stack(hs_list)
    new_pool_sample = jnp.stack(bs_list)
    return (xp, xs, new_hgrn_prompt, new_pool_prompt, new_hgrn_sample, new_pool_sample)
```

```cpp
#include <hip/hip_runtime.h>
#include <hip/hip_cooperative_groups.h>
#include <cstdio>
#include <cstdint>
namespace cg = cooperative_groups;
namespace pg8 {
#define PG8_LAS __attribute__((address_space(3)))
typedef unsigned short bf16_t;
typedef short bf16x8 __attribute__((ext_vector_type(8)));
typedef float f32x4 __attribute__((ext_vector_type(4)));
typedef unsigned u32x4 __attribute__((ext_vector_type(4)));
constexpr int BM = 256, BK = 64, HALF = 128, HTB = HALF * BK * 2  , STAGE_BYTES = 8 * HTB, NXCD = 8, WGM = 8;

__host__ __device__ __forceinline__ int lds_byte(int r, int c) { const int st = (r >> 4) * 2 + (c >> 5), rr = r & 15, cc = c & 31, ob = rr * 64 + cc * 2; return st * 1024 + (ob ^ (((ob >> 9) & 1) << 5)); }
__host__ __device__ __forceinline__ void stage_rc(int b, int& R, int& C) { const int st = b / 1024, sb = b % 1024, swz = sb ^ (((sb >> 9) & 1) << 5); R = (st >> 1) * 16 + swz / 64; C = (st & 1) * 32 + (swz % 64) / 2; }
__host__ __device__ __forceinline__ int perm32(int rho) { const int n = rho >> 4, i = rho & 15; return 8 * (i >> 2) + 4 * n + (i & 3); }

struct Unit { int pm, pn; };
struct Gemm { const bf16_t* A; const bf16_t* Bt; int M, N, K; };

struct StaticOrder {
    int nM, nN, nwg, G, c;
    __host__ __device__ void init(int M, int N, int G_, int c_) { nM = M / BM; nN = N / BM; nwg = nM * nN; G = G_; c = c_; }
    __host__ __device__ bool next(int i, Unit& u) const {
        const long L = (long)i * G + c; if (L >= nwg) return false;
        int wgid = (int)L; { const int q = nwg / NXCD, r = nwg % NXCD, xcd = wgid % NXCD, off = wgid / NXCD; wgid = (xcd < r ? xcd * (q + 1) : r * (q + 1) + (xcd - r) * q) + off; }
        const int nig = WGM * nN, gid = wgid / nig, fm = gid * WGM, gsz = (nM - fm) < WGM ? (nM - fm) : WGM;
        u.pm = fm + ((wgid % nig) % gsz); u.pn = (wgid % nig) / gsz; return true;
    }
    __device__ __forceinline__ void a_ready(const Unit&) const {}
    __device__ __forceinline__ void done(const Unit&) const {}
};

__device__ __forceinline__ unsigned cvt_pk_bf16(float lo, float hi) { unsigned r; asm volatile("v_cvt_pk_bf16_f32 %0, %1, %2" : "=v"(r) : "v"(lo), "v"(hi)); return r; }
typedef float f32x2 __attribute__((ext_vector_type(2)));
template <class Epi, class Sched, bool ALIGN_EPI = false, bool SP2 = false>
__device__ __forceinline__ void gemm_phase(PG8_LAS unsigned char* lds, const Gemm g, const Sched& S, const Epi& E) {
    int tid_ = threadIdx.x; asm volatile("" : "+v"(tid_));
    const int tid = tid_, wid = __builtin_amdgcn_readfirstlane(tid >> 6), lane = tid & 63, wr = wid >> 2, wc = wid & 3, fr = lane & 15, fq = lane >> 4;
    const int K = g.K, nt = K / BK;
    unsigned voffA[2], voffB[2];
#pragma unroll
    for (int i = 0; i < 2; ++i) { int R, C; stage_rc(tid * 16 + i * 8192, R, C); const int Rb = Epi::PERM ? ((R & ~31) + perm32(R & 31)) : R;
        voffA[i] = (unsigned)(R * K + C) * 2u; voffB[i] = (unsigned)(Rb * K + C) * 2u; }
    const size_t kstep = (size_t)(BK * 2);
    const size_t hstep = (size_t)HALF * K * 2;
    const size_t tstep = 2 * hstep;
    const unsigned ldsw = (unsigned)wid * 1024u;
    const int aoff = lds_byte(wr * 64 + fr, fq * 8), boff = lds_byte(wc * 32 + fr, fq * 8);
#define PG8_SA(b, h) (((b) * 2 + (h)) * HTB)
#define PG8_SB(b, h) ((4 + (b) * 2 + (h)) * HTB)
#define PG8_STAGE(bufoff, gbase, voff) do { _Pragma("unroll") for (int _i = 0; _i < 2; ++_i) \
        __builtin_amdgcn_global_load_lds((const unsigned*)((const char*)(gbase) + (voff)[_i]), (PG8_LAS unsigned*)(lds + (bufoff) + ldsw + _i * 8192), 16, 0, 0); } while (0)
#define PG8_LDA(dst, b, h) do { _Pragma("unroll") for (int m = 0; m < 4; ++m) _Pragma("unroll") for (int k = 0; k < 2; ++k) dst[m][k] = *(const PG8_LAS bf16x8*)(lds + PG8_SA(b, h) + aoff + m * 2048 + k * 1024); } while (0)
#define PG8_LDB(dst, b, h) do { _Pragma("unroll") for (int n = 0; n < 2; ++n) _Pragma("unroll") for (int k = 0; k < 2; ++k) dst[n][k] = *(const PG8_LAS bf16x8*)(lds + PG8_SB(b, h) + boff + n * 2048 + k * 1024); } while (0)
#define PG8_MMA(ai, bj, At, Bt) do { __builtin_amdgcn_s_setprio(1); _Pragma("unroll") for (int m = 0; m < 4; ++m) _Pragma("unroll") for (int n = 0; n < 2; ++n) _Pragma("unroll") for (int k = 0; k < 2; ++k) \
        acc[ai][bj][m][n] = __builtin_amdgcn_mfma_f32_16x16x32_bf16(Bt[n][k], At[m][k], acc[ai][bj][m][n], 0, 0, 0); __builtin_amdgcn_s_setprio(0); } while (0)
#define PG8_WAIT_V(n) asm volatile("s_waitcnt vmcnt(" #n ")" ::: "memory")
#define PG8_WAIT_L(n) asm volatile("s_waitcnt lgkmcnt(" #n ")" ::: "memory")
#define PG8_BAR __builtin_amdgcn_s_barrier()
#define PG8_SCHED __builtin_amdgcn_sched_barrier(0)
    Unit cur, nxt; int ui = 0;
    if (!S.next(0, cur)) return;
    f32x4 acc[2][2][4][2];
#pragma unroll
    for (int a = 0; a < 2; ++a)
#pragma unroll
        for (int b = 0; b < 2; ++b)
#pragma unroll
            for (int m = 0; m < 4; ++m)
#pragma unroll
                for (int n = 0; n < 2; ++n) acc[a][b][m][n] = (f32x4){0.f, 0.f, 0.f, 0.f};
    bf16x8 At[4][2], B0[2][2], B1[2][2];
    const char* cA = (const char*)g.A + (size_t)cur.pm * tstep; const char* cB = (const char*)g.Bt + (size_t)cur.pn * tstep;
    S.a_ready(cur);
    if constexpr (SP2) {
        PG8_STAGE(PG8_SB(0, 0), cB, voffB); PG8_STAGE(PG8_SB(0, 1), cB + hstep, voffB); PG8_STAGE(PG8_SA(0, 0), cA, voffA); PG8_STAGE(PG8_SA(0, 1), cA + hstep, voffA);
        if (wr == 1) PG8_BAR;
        PG8_WAIT_V(2); PG8_BAR;
        PG8_STAGE(PG8_SB(1, 0), cB + kstep, voffB); PG8_STAGE(PG8_SA(1, 0), cA + kstep, voffA); PG8_STAGE(PG8_SB(1, 1), cB + hstep + kstep, voffB);
        PG8_WAIT_V(6); PG8_BAR;
    } else {
        PG8_STAGE(PG8_SB(0, 0), cB, voffB); PG8_STAGE(PG8_SA(0, 0), cA, voffA); PG8_STAGE(PG8_SB(0, 1), cB + hstep, voffB); PG8_STAGE(PG8_SA(0, 1), cA + hstep, voffA);
        if (wr == 1) PG8_BAR;
        PG8_WAIT_V(4); PG8_BAR;
        PG8_STAGE(PG8_SB(1, 0), cB + kstep, voffB); PG8_STAGE(PG8_SA(1, 0), cA + kstep, voffA); PG8_STAGE(PG8_SB(1, 1), cB + hstep + kstep, voffB);
        PG8_WAIT_V(6); PG8_BAR;
    }
    for (;;) {
        const bool has_next = S.next(ui + 1, nxt);
        const char* nA = has_next ? (const char*)g.A + (size_t)nxt.pm * tstep : cA; const char* nB = has_next ? (const char*)g.Bt + (size_t)nxt.pn * tstep : cB;
        for (int t = 0; t < nt; t += 2) {
            const bool last = (t == nt - 2);
            const char* a1 = cA + (size_t)(t + 1) * kstep;
            const char* a2 = last ? nA : cA + (size_t)(t + 2) * kstep; const char* b2 = last ? nB : cB + (size_t)(t + 2) * kstep;
            const char* a3 = a2 + kstep; const char* b3 = b2 + kstep;
            if (last && has_next) S.a_ready(nxt);
            if constexpr (SP2) {
            PG8_LDB(B0, 0, 0); PG8_LDB(B1, 0, 1); PG8_SCHED; PG8_LDA(At, 0, 0); PG8_STAGE(PG8_SA(1, 1), a1 + hstep, voffA);
            PG8_WAIT_V(8); PG8_WAIT_L(0); PG8_BAR; PG8_MMA(0, 0, At, B0); PG8_MMA(0, 1, At, B1); PG8_BAR; PG8_SCHED;
            PG8_LDA(At, 0, 1); PG8_STAGE(PG8_SB(0, 0), b2, voffB); PG8_STAGE(PG8_SB(0, 1), b2 + hstep, voffB); PG8_STAGE(PG8_SA(0, 0), a2, voffA);
            PG8_WAIT_V(8); PG8_WAIT_L(0); PG8_BAR; PG8_MMA(1, 0, At, B0); PG8_MMA(1, 1, At, B1); PG8_BAR; PG8_SCHED;
            PG8_LDB(B0, 1, 0); PG8_LDB(B1, 1, 1); PG8_SCHED; PG8_LDA(At, 1, 0); PG8_STAGE(PG8_SA(0, 1), a2 + hstep, voffA);
            PG8_WAIT_V(8); PG8_WAIT_L(0); PG8_BAR; PG8_MMA(0, 0, At, B0); PG8_MMA(0, 1, At, B1); PG8_BAR; PG8_SCHED;
            PG8_LDA(At, 1, 1); PG8_STAGE(PG8_SB(1, 0), b3, voffB); PG8_STAGE(PG8_SB(1, 1), b3 + hstep, voffB); PG8_STAGE(PG8_SA(1, 0), a3, voffA);
            PG8_WAIT_V(8); PG8_WAIT_L(0); PG8_BAR; PG8_MMA(1, 0, At, B0); PG8_MMA(1, 1, At, B1); PG8_BAR; PG8_SCHED;
            } else {
            PG8_LDB(B0, 0, 0); PG8_SCHED; PG8_LDA(At, 0, 0); PG8_STAGE(PG8_SA(1, 1), a1 + hstep, voffA);
            PG8_WAIT_L(8); PG8_BAR; PG8_WAIT_L(0); PG8_MMA(0, 0, At, B0); PG8_BAR; PG8_SCHED;
            PG8_LDB(B1, 0, 1); PG8_STAGE(PG8_SB(0, 0), b2, voffB);
            PG8_BAR; PG8_WAIT_L(0); PG8_MMA(0, 1, At, B1); PG8_BAR;
            PG8_LDA(At, 0, 1); PG8_STAGE(PG8_SA(0, 0), a2, voffA);
            PG8_BAR; PG8_WAIT_L(0); PG8_MMA(1, 0, At, B0); PG8_BAR; PG8_SCHED;
            PG8_STAGE(PG8_SB(0, 1), b2 + hstep, voffB);
            PG8_WAIT_V(6); PG8_BAR; PG8_MMA(1, 1, At, B1); PG8_BAR;
            PG8_LDB(B0, 1, 0); PG8_SCHED; PG8_LDA(At, 1, 0); PG8_STAGE(PG8_SA(0, 1), a2 + hstep, voffA);
            PG8_WAIT_L(8); PG8_BAR; PG8_WAIT_L(0); PG8_MMA(0, 0, At, B0); PG8_BAR; PG8_SCHED;
            PG8_LDB(B1, 1, 1); PG8_STAGE(PG8_SB(1, 0), b3, voffB);
            PG8_BAR; PG8_WAIT_L(0); PG8_MMA(0, 1, At, B1); PG8_BAR;
            PG8_LDA(At, 1, 1); PG8_STAGE(PG8_SA(1, 0), a3, voffA);
            PG8_BAR; PG8_WAIT_L(0); PG8_MMA(1, 0, At, B0); PG8_BAR; PG8_SCHED;
            PG8_STAGE(PG8_SB(1, 1), b3 + hstep, voffB);
            PG8_WAIT_V(6); PG8_BAR; PG8_MMA(1, 1, At, B1); PG8_BAR;
            }
        }
        if constexpr (ALIGN_EPI) { if (wr == 0) PG8_BAR; }
        if constexpr (!Epi::AFTER_DRAIN) { E(acc, cur, wr, wc, fr, fq); S.done(cur); }
        if (!has_next) break;
#pragma unroll
        for (int a = 0; a < 2; ++a)
#pragma unroll
            for (int b = 0; b < 2; ++b)
#pragma unroll
                for (int m = 0; m < 4; ++m)
#pragma unroll
                    for (int n = 0; n < 2; ++n) acc[a][b][m][n] = (f32x4){0.f, 0.f, 0.f, 0.f};
        cur = nxt; cA = nA; cB = nB; ++ui;
        if constexpr (ALIGN_EPI) { if (wr == 1) PG8_BAR; }
    }
    PG8_WAIT_V(0);
    if constexpr (!ALIGN_EPI) { if (wr == 0) PG8_BAR; }
    PG8_BAR;
    if constexpr (Epi::AFTER_DRAIN) { E.fused(acc, cur, wr, wc, fr, fq, lds, wid, lane); S.done(cur); }
#undef PG8_SA
#undef PG8_SB
#undef PG8_STAGE
#undef PG8_LDA
#undef PG8_LDB
#undef PG8_MMA
#undef PG8_WAIT_V
#undef PG8_WAIT_L
#undef PG8_BAR
#undef PG8_SCHED
}
}

#define LAS __attribute__((address_space(3)))
using pg8::bf16_t; using pg8::bf16x8; using pg8::f32x4; using pg8::u32x4; using pg8::Unit;
typedef float f32x2_t __attribute__((ext_vector_type(2))); typedef __bf16 bf16x2_t __attribute__((ext_vector_type(2)));
__device__ __forceinline__ unsigned cvt_pk_bf16(float lo, float hi) { f32x2_t v = {lo, hi}; bf16x2_t b = __builtin_convertvector(v, bf16x2_t); return __builtin_bit_cast(unsigned, b); }
typedef unsigned u32x2 __attribute__((ext_vector_type(2)));
typedef short s16x4 __attribute__((ext_vector_type(4)));
constexpr int DM = 1024, MP = 16384, MS = 256, M = MP + MS, DFF = 2816, NIN = 6656, BW = 512, PLE = 256;
constexpr int SEQ = 8192, DSEQ = 32, PAST = 2048, NB_P = 2, NB_S = 8;
constexpr float EPS = 1e-6f;
constexpr int NWAVES = 8, NTHR = 512;
constexpr int LDS_BYTES = 147456;

constexpr size_t MiB = 1u << 20;
constexpr size_t U1 = (size_t)M * 1024 * 2;
constexpr size_t WS_SS = 0, WS_LB = 1 * MiB, WS_EG = 2 * MiB, WS_W = 4 * MiB;
constexpr size_t W_GU1 = WS_W, W_D1 = W_GU1 + (size_t)5632 * 1024 * 2, W_IN = W_D1 + (size_t)1024 * 2816 * 2, W_A = W_IN + (size_t)6656 * 1024 * 2,
                 W_POOL = W_A + (size_t)1024 * 1024 * 2, W_B = W_POOL + (size_t)512 * 512 * 2, W_OUT = W_B + (size_t)1024 * 512 * 2, W_GU2 = W_OUT + (size_t)1024 * 1024 * 2,
                 W_D2 = W_GU2 + (size_t)5632 * 1024 * 2, W_PP = W_D2 + (size_t)1024 * 2816 * 2, W_PG = W_PP + (size_t)1024 * 256 * 2, W_END = W_PG + (size_t)1024 * 1024 * 2;
constexpr size_t WS_H = 59 * MiB, WS_Y = WS_H + U1, WS_BIG = WS_Y + U1;
constexpr size_t B_QP = WS_BIG, B_KP = WS_BIG + 33 * MiB, B_VB = WS_BIG + 66 * MiB, B_O = B_VB  , B_OG = WS_BIG + 99 * MiB, B_GA = B_QP + MiB / 2, B_GB = B_KP + MiB / 2;
constexpr size_t B_ACT = WS_BIG, B_E = WS_BIG, B_PB = W_GU1  ;
constexpr size_t WS_U = WS_Y, WS_POOLED = WS_Y + (size_t)M * 512 * 2, WS_PM = W_GU1  ;
constexpr size_t WS_NEED = B_OG + U1;
static_assert(W_END <= WS_H && WS_NEED <= 256 * MiB && (size_t)M * DFF * 2 <= 131 * MiB && U1 <= 33 * MiB - MiB / 2, "d_ws map");
constexpr size_t O_Y = 0, O_HP = (size_t)M * DM, O_PP = O_HP + (size_t)NB_P * 8 * 128 * 128, O_HS = O_PP + (size_t)NB_P * 15 * 512, O_PS = O_HS + (size_t)NB_S * 8 * 128 * 128;

__device__ __forceinline__ float bf2f(unsigned short v) { return __uint_as_float((unsigned)v << 16); }
__device__ __forceinline__ float bflo(unsigned w) { return __uint_as_float(w << 16); }
__device__ __forceinline__ float bfhi(unsigned w) { return __uint_as_float(w & 0xffff0000u); }
__device__ __forceinline__ f32x4 zero_acc() { f32x4 z = (f32x4){0.f, 0.f, 0.f, 0.f}; asm volatile("" : "+v"(z)); return z; }
__device__ __forceinline__ int otid() { int t = threadIdx.x; asm volatile("" : "+v"(t)); return t; }
__device__ __forceinline__ float fexp(float x) { return __builtin_amdgcn_exp2f(x * 1.44269504f); }
__device__ __forceinline__ float flog(float x) { return __builtin_amdgcn_logf(x) * 0.69314718f; }
__device__ __forceinline__ float frcp(float x) { return __builtin_amdgcn_rcpf(x); }
__device__ __forceinline__ float sigm(float x) { return frcp(1.0f + fexp(-x)); }
__device__ __forceinline__ float wave_sum(float v) {
#pragma unroll
    for (int o = 1; o < 64; o <<= 1) v += __shfl_xor(v, o);
    return v;
}
template <int CTRL> __device__ __forceinline__ float dppm(float x) { return __int_as_float(__builtin_amdgcn_update_dpp(0x3f800000, __float_as_int(x), CTRL, 0xf, 0xf, false)); }
template <int CTRL> __device__ __forceinline__ float dppf(float x) { return __int_as_float(__builtin_amdgcn_update_dpp(0, __float_as_int(x), CTRL, 0xf, 0xf, true)); }

struct TileSched {
    int nNp, pn0p, nNs, pn0s, nwgP, G, c;
    __device__ __forceinline__ void init(int nNp_, int pn0p_, int nNs_, int pn0s_, int G_, int c_) { nNp = nNp_; pn0p = pn0p_; nNs = nNs_; pn0s = pn0s_; nwgP = 64 * nNp_; G = G_; c = c_; }
    __device__ __forceinline__ bool next(int i, Unit& u) const {
        long L = (long)i * G + c;
        if (L < nwgP) {
            int wgid = (int)L; { const int q = nwgP / 8, xcd = wgid % 8, off = wgid / 8; wgid = xcd * q + off; }
            const int nig = 8 * nNp, gid = wgid / nig, fm = gid * 8;
            u.pm = fm + ((wgid % nig) % 8); u.pn = pn0p + (wgid % nig) / 8; return true;
        }
        L -= nwgP;
        if (L < nNs) { u.pm = 64; u.pn = pn0s + (int)L; return true; }
        return false;
    }
    __device__ __forceinline__ void a_ready(const Unit&) const {}
    __device__ __forceinline__ void done(const Unit&) const {}
};

#define EPI_ROWS(ai, m) (u.pm * 256 + (ai) * 128 + wr * 64 + (m) * 16 + fr)
__device__ __forceinline__ u32x4 pack8(const f32x4& a, const f32x4& b) { u32x4 w; w.x = cvt_pk_bf16(a[0], a[1]); w.y = cvt_pk_bf16(a[2], a[3]); w.z = cvt_pk_bf16(b[0], b[1]); w.w = cvt_pk_bf16(b[2], b[3]); return w; }
__device__ __forceinline__ void unpack8(const u32x4& w, f32x4& a, f32x4& b) { a = (f32x4){bflo(w.x), bfhi(w.x), bflo(w.y), bfhi(w.y)}; b = (f32x4){bflo(w.z), bfhi(w.z), bflo(w.w), bfhi(w.w)}; }

struct EpiSwiGLU {
    static constexpr bool PERM = true, AFTER_DRAIN = false;
    bf16_t* O;
    __device__ __forceinline__ void operator()(f32x4 (&acc)[2][2][4][2], const Unit& u, int wr, int wc, int fr, int fq) const {
        const int col0 = u.pn * 128 + wc * 32 + 8 * fq;
#pragma unroll
        for (int ai = 0; ai < 2; ++ai)
#pragma unroll
            for (int m = 0; m < 4; ++m) {
                f32x4 o[2];
#pragma unroll
                for (int n = 0; n < 2; ++n)
#pragma unroll
                    for (int j = 0; j < 4; ++j) { const float a = acc[ai][0][m][n][j], b = acc[ai][1][m][n][j]; o[n][j] = a * sigm(a) * b; }
                *(u32x4*)(O + (size_t)EPI_ROWS(ai, m) * DFF + col0) = pack8(o[0], o[1]);
            }
    }
};
template <bool SCALE> struct EpiStore {
    static constexpr bool PERM = true, AFTER_DRAIN = false;
    bf16_t* O; int ldc; const float* scale;
    __device__ __forceinline__ void operator()(f32x4 (&acc)[2][2][4][2], const Unit& u, int wr, int wc, int fr, int fq) const {
#pragma unroll
        for (int bj = 0; bj < 2; ++bj) {
            const int col0 = u.pn * 256 + bj * 128 + wc * 32 + 8 * fq;
            f32x4 s0 = (f32x4){1.f, 1.f, 1.f, 1.f}, s1 = s0;
            if (SCALE) { s0 = *(const f32x4*)(scale + col0); s1 = *(const f32x4*)(scale + col0 + 4); }
#pragma unroll
            for (int ai = 0; ai < 2; ++ai)
#pragma unroll
                for (int m = 0; m < 4; ++m) *(u32x4*)(O + (size_t)EPI_ROWS(ai, m) * ldc + col0) = pack8(acc[ai][bj][m][0] * s0, acc[ai][bj][m][1] * s1);
        }
    }
};
struct EpiMulInPlace {
    static constexpr bool PERM = true, AFTER_DRAIN = false;
    bf16_t* Gt;
    __device__ __forceinline__ void operator()(f32x4 (&acc)[2][2][4][2], const Unit& u, int wr, int wc, int fr, int fq) const {
#pragma unroll
        for (int bj = 0; bj < 2; ++bj) {
            const int col0 = u.pn * 256 + bj * 128 + wc * 32 + 8 * fq;
#pragma unroll
            for (int ai = 0; ai < 2; ++ai)
#pragma unroll
                for (int m = 0; m < 4; ++m) { bf16_t* p = Gt + (size_t)EPI_ROWS(ai, m) * DM + col0; f32x4 g0, g1; unpack8(*(const u32x4*)p, g0, g1);
                    *(u32x4*)p = pack8(g0 * acc[ai][bj][m][0], g1 * acc[ai][bj][m][1]); }
        }
    }
};
struct EpiFmaInPlace {
    static constexpr bool PERM = true, AFTER_DRAIN = false;
    const bf16_t* T1; bf16_t* Gb;
    __device__ __forceinline__ void operator()(f32x4 (&acc)[2][2][4][2], const Unit& u, int wr, int wc, int fr, int fq) const {
#pragma unroll
        for (int bj = 0; bj < 2; ++bj) {
            const int col0 = u.pn * 256 + bj * 128 + wc * 32 + 8 * fq;
#pragma unroll
            for (int ai = 0; ai < 2; ++ai)
#pragma unroll
                for (int m = 0; m < 4; ++m) { const size_t off = (size_t)EPI_ROWS(ai, m) * DM + col0; f32x4 g0, g1, t0, t1; unpack8(*(const u32x4*)(Gb + off), g0, g1); unpack8(*(const u32x4*)(T1 + off), t0, t1);
                    *(u32x4*)(Gb + off) = pack8(t0 + g0 * acc[ai][bj][m][0], t1 + g1 * acc[ai][bj][m][1]); }
        }
    }
};
struct EpiPleGate {
    static constexpr bool PERM = true, AFTER_DRAIN = false;
    const bf16_t* E; bf16_t* O;
    __device__ __forceinline__ void operator()(f32x4 (&acc)[2][2][4][2], const Unit& u, int wr, int wc, int fr, int fq) const {
#pragma unroll
        for (int bj = 0; bj < 2; ++bj) {
            const int col0 = u.pn * 256 + bj * 128 + wc * 32 + 8 * fq;
#pragma unroll
            for (int ai = 0; ai < 2; ++ai)
#pragma unroll
                for (int m = 0; m < 4; ++m) { const size_t off = (size_t)EPI_ROWS(ai, m) * DM + col0; f32x4 e0, e1; unpack8(*(const u32x4*)(E + off), e0, e1); f32x4 o0, o1;
#pragma unroll
                    for (int j = 0; j < 4; ++j) { o0[j] = sigm(acc[ai][bj][m][0][j]) * e0[j]; o1[j] = sigm(acc[ai][bj][m][1][j]) * e1[j]; }
                    *(u32x4*)(O + off) = pack8(o0, o1); }
        }
    }
};
struct EpiIn {
    static constexpr bool PERM = true, AFTER_DRAIN = false;
    unsigned char* ws; float* EG; const float* lb;
    __device__ __forceinline__ void operator()(f32x4 (&acc)[2][2][4][2], const Unit& u, int wr, int wc, int fr, int fq) const {
        const int cin = wc * 32 + 8 * fq;
        bf16_t* Qp = (bf16_t*)(ws + B_QP); bf16_t* Kp = (bf16_t*)(ws + B_KP);
        if (u.pn < 8) {
            const int h = u.pn; const bool smp = (u.pm == 64);
            const f32x4 lb0 = *(const f32x4*)(lb + h * 128 + cin), lb1 = *(const f32x4*)(lb + h * 128 + cin + 4);
#pragma unroll
            for (int ai = 0; ai < 2; ++ai) {
                f32x4 egA[2], egB[2];
#pragma unroll
                for (int n = 0; n < 2; ++n)
#pragma unroll
                    for (int j = 0; j < 4; ++j) {
                        const float lbv = n ? lb1[j] : lb0[j], omlb = 1.0f - lbv;
                        float inc[4], tot[4], kk[4];
#pragma unroll
                        for (int m = 0; m < 4; ++m) {
                            float fz = acc[ai][1][m][n][j]; fz = fminf(fmaxf(fz, -30.f), 30.f);
                            const float e = fexp(-fz), sg = frcp(1.0f + e);
                            kk[m] = omlb * e * sg;
                            float x = lbv + omlb * sg;
                            x *= dppm<0x111>(x); x *= dppm<0x112>(x); x *= dppm<0x114>(x); x *= dppm<0x118>(x);
                            inc[m] = x; tot[m] = dppf<0x15F>(x);
                        }
                        const float off1 = tot[0], off2 = smp ? 1.f : tot[0] * tot[1], off3 = off2 * tot[2];
                        const float lastA = smp ? tot[0] * tot[1] : off3 * tot[3], lastB = tot[2] * tot[3];
                        const float g[4] = {inc[0], inc[1] * off1, inc[2] * off2, inc[3] * off3};
#pragma unroll
                        for (int m = 0; m < 4; ++m) {
                            const float q = acc[ai][0][m][n][j];
                            const float eg_ = g[m], d_ = 1.0f + fexp(-fmaxf(q, -30.f)), r_ = frcp(d_ * eg_);
                            acc[ai][0][m][n][j] = (q * eg_) * (eg_ * r_);
                            acc[ai][1][m][n][j] = kk[m] * (d_ * r_);
                        }
                        egA[n][j] = lastA; egB[n][j] = lastB;
                    }
#pragma unroll
                for (int m = 0; m < 4; ++m) { const size_t off = (size_t)EPI_ROWS(ai, m) * DM + h * 128 + cin;
                    *(u32x4*)(Qp + off) = pack8(acc[ai][0][m][0], acc[ai][0][m][1]); *(u32x4*)(Kp + off) = pack8(acc[ai][1][m][0], acc[ai][1][m][1]); }
                if (fr == 0) {
                    if (!smp) { float* p = EG + (size_t)(u.pm * 4 + ai * 2 + wr) * 1024 + h * 128 + cin; *(f32x4*)p = egA[0]; *(f32x4*)(p + 4) = egA[1]; }
                    else { float* p = EG + (size_t)(256 + ai * 4 + wr * 2) * 1024 + h * 128 + cin; *(f32x4*)p = egA[0]; *(f32x4*)(p + 4) = egA[1]; *(f32x4*)(p + 1024) = egB[0]; *(f32x4*)(p + 1028) = egB[1]; }
                }
            }
            return;
        }
        size_t boff; int ldc, c0, act;
        if (u.pn < 12) { boff = B_VB; ldc = 1024; c0 = (u.pn - 8) * 256; act = 0; }
        else if (u.pn < 14) { boff = WS_U; ldc = 512; c0 = (u.pn - 12) * 256; act = 0; }
        else if (u.pn < 18) { boff = B_OG; ldc = 1024; c0 = (u.pn - 14) * 256; act = 1; }
        else if (u.pn < 22) { boff = B_GA; ldc = 1024; c0 = (u.pn - 18) * 256; act = 2; }
        else { boff = B_GB; ldc = 1024; c0 = (u.pn - 22) * 256; act = 2; }
        bf16_t* O = (bf16_t*)(ws + boff);
#pragma unroll
        for (int bj = 0; bj < 2; ++bj)
#pragma unroll
            for (int ai = 0; ai < 2; ++ai)
#pragma unroll
                for (int m = 0; m < 4; ++m) {
                    f32x4 o[2];
#pragma unroll
                    for (int n = 0; n < 2; ++n)
#pragma unroll
                        for (int j = 0; j < 4; ++j) { const float x = acc[ai][bj][m][n][j]; const float s = sigm(x); o[n][j] = act == 0 ? x : (act == 1 ? x * s : s); }
                    *(u32x4*)(O + (size_t)EPI_ROWS(ai, m) * ldc + c0 + bj * 128 + cin) = pack8(o[0], o[1]);
                }
    }
};

__device__ __forceinline__ u32x2 pack4(const f32x4& a) { u32x2 w; w.x = cvt_pk_bf16(a[0], a[1]); w.y = cvt_pk_bf16(a[2], a[3]); return w; }
__device__ __forceinline__ f32x4 unpack4(const u32x2& w) { return (f32x4){bflo(w.x), bfhi(w.x), bflo(w.y), bfhi(w.y)}; }
struct SStore { bf16_t* O; int ldc; const float* scale;
    __device__ __forceinline__ void operator()(int row, int col, f32x4 v) const { if (scale) v = v * *(const f32x4*)(scale + col); *(u32x2*)(O + (size_t)row * ldc + col) = pack4(v); } };
struct SMulInPlace { bf16_t* Gt;
    __device__ __forceinline__ void operator()(int row, int col, f32x4 v) const { bf16_t* p = Gt + (size_t)row * DM + col; *(u32x2*)p = pack4(unpack4(*(const u32x2*)p) * v); } };
struct SFmaInPlace { const bf16_t* T1; bf16_t* Gb;
    __device__ __forceinline__ void operator()(int row, int col, f32x4 v) const { const size_t off = (size_t)row * DM + col; *(u32x2*)(Gb + off) = pack4(unpack4(*(const u32x2*)(T1 + off)) + unpack4(*(const u32x2*)(Gb + off)) * v); } };
struct SPleGate { const bf16_t* E; bf16_t* O;
    __device__ __forceinline__ void operator()(int row, int col, f32x4 v) const { const size_t off = (size_t)row * DM + col; const f32x4 e = unpack4(*(const u32x2*)(E + off)); f32x4 o;
#pragma unroll
        for (int j = 0; j < 4; ++j) o[j] = sigm(v[j]) * e[j];
        *(u32x2*)(O + off) = pack4(o); } };
template <class Epi> __device__ __forceinline__ void sgemm_sample(LAS unsigned char* lds, const bf16_t* A, const bf16_t* Bt, int N, int K, const Epi& E, int bx, int G, int wave, int lane) {
    const int fr = lane & 15, fq = lane >> 4, nblk = N >> 2, per = K >> 8;
    LAS f32x4* slots = (LAS f32x4*)lds;
    for (int bt = bx; bt < nblk; bt += G) {
        const int rb = bt & 7, cb = bt >> 3;
        const bf16_t* ap = A + (size_t)(MP + 32 * rb + fr) * K + 32 * (wave * per) + 8 * fq;
        const bf16_t* bp = Bt + (size_t)(32 * cb + fr) * K + 32 * (wave * per) + 8 * fq;
        const size_t r16 = (size_t)16 * K;
        f32x4 acc00 = zero_acc(), acc01 = zero_acc(), acc10 = zero_acc(), acc11 = zero_acc();
        for (int s0 = 0; s0 < per; s0 += 4) {
            bf16x8 a0[4], a1[4], b0[4], b1[4];
#pragma unroll
            for (int u = 0; u < 4; ++u) { const int su = (s0 + u < per) ? s0 + u : per - 1;
                a0[u] = *(const bf16x8*)(ap + 32 * su); a1[u] = *(const bf16x8*)(ap + r16 + 32 * su); b0[u] = *(const bf16x8*)(bp + 32 * su); b1[u] = *(const bf16x8*)(bp + r16 + 32 * su); }
#pragma unroll
            for (int u = 0; u < 4; ++u) { if (s0 + u < per) {
                acc00 = __builtin_amdgcn_mfma_f32_16x16x32_bf16(b0[u], a0[u], acc00, 0, 0, 0); acc01 = __builtin_amdgcn_mfma_f32_16x16x32_bf16(b1[u], a0[u], acc01, 0, 0, 0);
                acc10 = __builtin_amdgcn_mfma_f32_16x16x32_bf16(b0[u], a1[u], acc10, 0, 0, 0); acc11 = __builtin_amdgcn_mfma_f32_16x16x32_bf16(b1[u], a1[u], acc11, 0, 0, 0); } }
        }
        __syncthreads();
        slots[(wave * 4 + 0) * 64 + lane] = acc00; slots[(wave * 4 + 1) * 64 + lane] = acc01; slots[(wave * 4 + 2) * 64 + lane] = acc10; slots[(wave * 4 + 3) * 64 + lane] = acc11;
        __syncthreads();
        if (wave < 4) {
            f32x4 sum = slots[(0 * 4 + wave) * 64 + lane];
#pragma unroll
            for (int w = 1; w < 8; ++w) sum = sum + slots[(w * 4 + wave) * 64 + lane];
            const int i = wave >> 1, j = wave & 1;
            E(MP + 32 * rb + 16 * i + fr, 32 * cb + 16 * j + 4 * fq, sum);
        }
    }
    __syncthreads();
}

__device__ __forceinline__ unsigned pk2(float lo, float hi) { return cvt_pk_bf16(lo, hi); }
__device__ __forceinline__ void transpose_item(const float* W, int ldn, int src_n0, int K, bf16_t* WT, int dst_n0, int k0, LAS float* scr, int lane) {
    const int nq = (lane & 7) * 4, kr = lane >> 3;
    f32x4 v[8];
#pragma unroll
    for (int i = 0; i < 8; ++i) v[i] = *(const f32x4*)(W + (size_t)(k0 + 8 * i + kr) * ldn + src_n0 + nq);
#pragma unroll
    for (int i = 0; i < 8; ++i) { LAS float* d = scr + (8 * i + kr) * 33 + nq; d[0] = v[i].x; d[1] = v[i].y; d[2] = v[i].z; d[3] = v[i].w; }
    asm volatile("s_waitcnt lgkmcnt(0)" ::: "memory");
    const int c = lane & 7;
#pragma unroll
    for (int j = 0; j < 4; ++j) { const int n = (lane >> 3) + 8 * j; const LAS float* s = scr + (8 * c) * 33 + n;
        u32x4 o; o.x = pk2(s[0 * 33], s[1 * 33]); o.y = pk2(s[2 * 33], s[3 * 33]); o.z = pk2(s[4 * 33], s[5 * 33]); o.w = pk2(s[6 * 33], s[7 * 33]);
        *(u32x4*)(WT + (size_t)(dst_n0 + n) * K + k0 + 8 * c) = o; }
    asm volatile("s_waitcnt lgkmcnt(0)" ::: "memory");
}
__device__ __forceinline__ int map_gu(int n) { const int pn = n >> 8, bj = (n >> 7) & 1, jj = n & 127; return bj * DFF + pn * 128 + jj; }
__device__ __forceinline__ int map_in(int n) {
    if (n < 2048) { const int h = n >> 8, bj = (n >> 7) & 1, kk = n & 127; return bj * 1024 + h * 128 + kk; }
    if (n < 3072) return n;
    if (n < 3584) return 4096 + (n - 3072);
    if (n < 4608) return 3072 + (n - 3584);
    return n;
}
__device__ __forceinline__ void rms_row_to_bf16(const float* xrow, const float* g, bf16_t* orow, int lane) {
    const f32x4* xr = (const f32x4*)xrow + lane; f32x4 v[4]; float s = 0.f;
#pragma unroll
    for (int j = 0; j < 4; ++j) { v[j] = xr[64 * j]; s += (v[j].x * v[j].x + v[j].y * v[j].y) + (v[j].z * v[j].z + v[j].w * v[j].w); }
    const float r = rsqrtf(wave_sum(s) * (1.f / 1024.f) + EPS);
    u32x2* o8 = (u32x2*)orow + lane;
#pragma unroll
    for (int j = 0; j < 4; ++j) { const f32x4 gg = ((const f32x4*)g)[lane + 64 * j]; u32x2 w; w.x = pk2(v[j].x * r * gg.x, v[j].y * r * gg.y); w.y = pk2(v[j].z * r * gg.z, v[j].w * r * gg.w); o8[64 * j] = w; }
}
template <bool HAS_H> __device__ __forceinline__ void row_phase(const bf16_t* Y, const float* xin_p, const float* xin_s, float* xout, bf16_t* H, const float* g_post, float coef, const float* g_pre, int gw, int NGW, int lane) {
    for (int m = gw; m < M; m += NGW) {
        const float* xi = (m < MP) ? xin_p + (size_t)m * DM : xin_s + (size_t)(m - MP) * DM;
        const u32x2* yr = (const u32x2*)(Y + (size_t)m * DM) + lane; f32x4 y[4], x[4]; float s = 0.f;
#pragma unroll
        for (int j = 0; j < 4; ++j) { const u32x2 w = yr[64 * j]; y[j] = (f32x4){bflo(w.x), bfhi(w.x), bflo(w.y), bfhi(w.y)}; x[j] = ((const f32x4*)xi)[lane + 64 * j];
            s += (y[j].x * y[j].x + y[j].y * y[j].y) + (y[j].z * y[j].z + y[j].w * y[j].w); }
        const float r = rsqrtf(wave_sum(s) * (1.f / 1024.f) + EPS) * coef; float s2 = 0.f;
#pragma unroll
        for (int j = 0; j < 4; ++j) { const f32x4 gg = ((const f32x4*)g_post)[lane + 64 * j]; x[j] = x[j] + y[j] * gg * r; ((f32x4*)(xout + (size_t)m * DM))[lane + 64 * j] = x[j];
            s2 += (x[j].x * x[j].x + x[j].y * x[j].y) + (x[j].z * x[j].z + x[j].w * x[j].w); }
        if (HAS_H) {
            const float r2 = rsqrtf(wave_sum(s2) * (1.f / 1024.f) + EPS); u32x2* o8 = (u32x2*)(H + (size_t)m * DM) + lane;
#pragma unroll
            for (int j = 0; j < 4; ++j) { const f32x4 gg = ((const f32x4*)g_pre)[lane + 64 * j]; u32x2 w; w.x = pk2(x[j].x * r2 * gg.x, x[j].y * r2 * gg.y); w.y = pk2(x[j].z * r2 * gg.z, x[j].w * r2 * gg.w); o8[64 * j] = w; }
        }
    }
}

constexpr int HP = 136, L_QKBUF = 2 * 64 * HP * 2, L_KOFF = 64 * HP * 2, L_VT = 2 * L_QKBUF, L_VTSZ = 16 * 72 * 2, L_AL = L_VT + 2 * L_VTSZ, L_ALSZ = 64 * 72 * 2, L_ST = L_AL + 2 * L_ALSZ, L_STSZ = 16 * HP * 2;
static_assert(L_ST + 2 * L_STSZ <= 131072, "hgrn lds");
#define HG_LOAD2(c, RQ, RK, RV, EGN) do { _Pragma("unroll") for (int j_ = 0; j_ < 2; ++j_) { const int row_ = prow0 + 32 * j_, rowc_ = row_ < T ? row_ : T - 1; const size_t go_ = (size_t)(row0 + (c) * 64 + rowc_) * DM + qcol + pch * 8; \
            RQ[j_] = *(const u32x4*)(Qp + go_); RK[j_] = *(const u32x4*)(Kp + go_); } \
            { const int vrc_ = vrow < T ? vrow : T - 1; RV = *(const u32x4*)(Vb + (size_t)(row0 + (c) * 64 + vrc_) * DM + vcol + vhalf * 8); } \
            EGN = *(const f32x4*)(EG + (size_t)(cid0 + (c)) * 1024 + h * 128 + 16 * wave + 4 * fq); } while (0)
#define HG_WRITE2(bf, RQ, RK, RV) do { LAS unsigned char* qb_ = lds + (bf) * L_QKBUF; _Pragma("unroll") for (int j_ = 0; j_ < 2; ++j_) { const int row_ = prow0 + 32 * j_; const bool z_ = row_ >= T; \
            u32x4 q_ = RQ[j_], k_ = RK[j_]; if (z_) { q_ = (u32x4){0u, 0u, 0u, 0u}; k_ = q_; } \
            *(LAS u32x4*)(qb_ + (row_ * HP + pch * 8) * 2) = q_; *(LAS u32x4*)(qb_ + L_KOFF + (row_ * HP + pch * 8) * 2) = k_; } \
            if (tid < 128) { u32x4 v_ = RV; if (vrow >= T) v_ = (u32x4){0u, 0u, 0u, 0u}; LAS unsigned short* vt_ = (LAS unsigned short*)(lds + L_VT + (bf) * L_VTSZ) + (vhalf * 8) * 72 + vrow; \
                vt_[0 * 72] = (unsigned short)v_.x; vt_[1 * 72] = (unsigned short)(v_.x >> 16); vt_[2 * 72] = (unsigned short)v_.y; vt_[3 * 72] = (unsigned short)(v_.y >> 16); \
                vt_[4 * 72] = (unsigned short)v_.z; vt_[5 * 72] = (unsigned short)(v_.z >> 16); vt_[6 * 72] = (unsigned short)v_.w; vt_[7 * 72] = (unsigned short)(v_.w >> 16); } } while (0)
#define HG_STEP(cc) do { const int c_ = (cc); const int bf = c_ & 1; \
            if (wave < 4 && c_ > 0) { \
                const LAS unsigned char* ALp = lds + L_AL + (bf ^ 1) * L_ALSZ; \
                const int tt = wave, nks = (tt >> 1) + 1; \
                { const bf16x8 af = *(const LAS bf16x8*)(ALp + ((16 * tt + fr) * 72 + 8 * fq) * 2); oprev = __builtin_amdgcn_mfma_f32_16x16x32_bf16(vprev0, af, oprev, 0, 0, 0); } \
                if (nks > 1) { const bf16x8 af = *(const LAS bf16x8*)(ALp + ((16 * tt + fr) * 72 + 32 + 8 * fq) * 2); oprev = __builtin_amdgcn_mfma_f32_16x16x32_bf16(vprev1, af, oprev, 0, 0, 0); } \
                const int t = 16 * tt + fr; \
                if (t < T) { const size_t grow = (size_t)(row0 + (c_ - 1) * 64 + t); u32x2 w; w.x = pk2(oprev[0], oprev[1]); w.y = pk2(oprev[2], oprev[3]); *(u32x2*)(Ob + grow * DM + vcol + 4 * fq) = w; } \
            } \
            if (c_ < nch) { \
            const LAS unsigned char* QL = lds + bf * L_QKBUF; const LAS unsigned char* KL = QL + L_KOFF; const LAS unsigned char* VT = lds + L_VT + bf * L_VTSZ; \
            const LAS unsigned char* STo = lds + L_ST + bf * L_STSZ; LAS unsigned char* STn = lds + L_ST + (bf ^ 1) * L_STSZ; LAS unsigned char* AL = lds + L_AL + bf * L_ALSZ; \
            f32x4 oacc = zero_acc(); \
            if (wave < 4) { \
                const int tt = wave; bf16x8 qf[4]; \
_Pragma("unroll") \
                for (int ks = 0; ks < 4; ++ks) qf[ks] = *(const LAS bf16x8*)(QL + ((16 * tt + fr) * HP + 32 * ks + 8 * fq) * 2); \
                f32x4 a = zero_acc(); \
_Pragma("unroll") \
                for (int ks = 0; ks < 4; ++ks) { const bf16x8 kf = *(const LAS bf16x8*)(KL + ((16 * tt + fr) * HP + 32 * ks + 8 * fq) * 2); a = __builtin_amdgcn_mfma_f32_16x16x32_bf16(kf, qf[ks], a, 0, 0, 0); } \
_Pragma("unroll") \
                for (int i = 0; i < 4; ++i) if (4 * fq + i > fr) a[i] = 0.f; \
                { u32x2 w; w.x = pk2(a[0], a[1]); w.y = pk2(a[2], a[3]); *(LAS u32x2*)(AL + ((16 * tt + fr) * 72 + 16 * tt + 4 * fq) * 2) = w; } \
_Pragma("unroll") \
                for (int ks = 0; ks < 4; ++ks) { const bf16x8 sf = *(const LAS bf16x8*)(STo + (fr * HP + 32 * ks + 8 * fq) * 2); oacc = __builtin_amdgcn_mfma_f32_16x16x32_bf16(sf, qf[ks], oacc, 0, 0, 0); } \
            } else { \
                if (wave == 4) { bf16x8 kf[4];   \
_Pragma("unroll") \
                    for (int ks = 0; ks < 4; ++ks) kf[ks] = *(const LAS bf16x8*)(KL + (fr * HP + 32 * ks + 8 * fq) * 2); \
_Pragma("unroll") \
                    for (int tt = 1; tt < 3; ++tt) { f32x4 a = zero_acc(); \
_Pragma("unroll") \
                        for (int ks = 0; ks < 4; ++ks) { const bf16x8 qf = *(const LAS bf16x8*)(QL + ((16 * tt + fr) * HP + 32 * ks + 8 * fq) * 2); a = __builtin_amdgcn_mfma_f32_16x16x32_bf16(kf[ks], qf, a, 0, 0, 0); } \
                        u32x2 w; w.x = pk2(a[0], a[1]); w.y = pk2(a[2], a[3]); *(LAS u32x2*)(AL + ((16 * tt + fr) * 72 + 4 * fq) * 2) = w; } \
                } else if (wave == 5) { bf16x8 qf[4];   \
_Pragma("unroll") \
                    for (int ks = 0; ks < 4; ++ks) qf[ks] = *(const LAS bf16x8*)(QL + ((48 + fr) * HP + 32 * ks + 8 * fq) * 2); \
_Pragma("unroll") \
                    for (int st = 0; st < 2; ++st) { f32x4 a = zero_acc(); \
_Pragma("unroll") \
                        for (int ks = 0; ks < 4; ++ks) { const bf16x8 kf = *(const LAS bf16x8*)(KL + ((16 * st + fr) * HP + 32 * ks + 8 * fq) * 2); a = __builtin_amdgcn_mfma_f32_16x16x32_bf16(kf, qf[ks], a, 0, 0, 0); } \
                        u32x2 w; w.x = pk2(a[0], a[1]); w.y = pk2(a[2], a[3]); *(LAS u32x2*)(AL + ((48 + fr) * 72 + 16 * st + 4 * fq) * 2) = w; } \
                } else { const int tt = (wave == 6) ? 2 : 3, st = tt - 1;   \
                    f32x4 a = zero_acc(); \
_Pragma("unroll") \
                    for (int ks = 0; ks < 4; ++ks) { const bf16x8 kf = *(const LAS bf16x8*)(KL + ((16 * st + fr) * HP + 32 * ks + 8 * fq) * 2); const bf16x8 qf = *(const LAS bf16x8*)(QL + ((16 * tt + fr) * HP + 32 * ks + 8 * fq) * 2); \
                        a = __builtin_amdgcn_mfma_f32_16x16x32_bf16(kf, qf, a, 0, 0, 0); } \
                    u32x2 w; w.x = pk2(a[0], a[1]); w.y = pk2(a[2], a[3]); *(LAS u32x2*)(AL + ((16 * tt + fr) * 72 + 16 * st + 4 * fq) * 2) = w; \
                } \
            } \
            bf16x8 vf[2]; \
_Pragma("unroll") \
            for (int ks = 0; ks < 2; ++ks) vf[ks] = *(const LAS bf16x8*)(VT + (fr * 72 + 32 * ks + 8 * fq) * 2); \
            {   \
              const unsigned ka_ = (unsigned)(__UINTPTR_TYPE__)KL + (unsigned)((8 * fq + (fr >> 2)) * (HP * 2) + 32 * wave + 8 * (fr & 3)); \
              s16x4 k00, k01, k10, k11; \
              asm volatile("ds_read_b64_tr_b16 %0, %4\n\tds_read_b64_tr_b16 %1, %4 offset:%5\n\tds_read_b64_tr_b16 %2, %4 offset:%6\n\tds_read_b64_tr_b16 %3, %4 offset:%7\n\ts_waitcnt lgkmcnt(0)" \
                           : "=&v"(k00), "=&v"(k01), "=&v"(k10), "=&v"(k11) : "v"(ka_), "n"(4 * HP * 2), "n"(32 * HP * 2), "n"(36 * HP * 2) : "memory"); \
              const bf16x8 kt0 = __builtin_shufflevector(k00, k01, 0, 1, 2, 3, 4, 5, 6, 7), kt1 = __builtin_shufflevector(k10, k11, 0, 1, 2, 3, 4, 5, 6, 7); \
              S = __builtin_amdgcn_mfma_f32_16x16x32_bf16(kt0, vf[0], S, 0, 0, 0); S = __builtin_amdgcn_mfma_f32_16x16x32_bf16(kt1, vf[1], S, 0, 0, 0); } \
            { S = S * eg; \
              u32x2 w; w.x = pk2(S[0], S[1]); w.y = pk2(S[2], S[3]); *(LAS u32x2*)(STn + (fr * HP + 16 * wave + 4 * fq) * 2) = w; } \
            oprev = oacc; vprev0 = vf[0]; vprev1 = vf[1]; \
            } \
        } while (0)
__device__ __forceinline__ void hgrn_phase(LAS unsigned char* lds, const bf16_t* Qp, const bf16_t* Kp, const bf16_t* Vb, bf16_t* Ob, const float* EG, const float* state_in, float* out_hp, float* out_hs, int G, int bx, int tid) {
    const int wave = __builtin_amdgcn_readfirstlane(tid >> 6), lane = tid & 63, fr = lane & 15, fq = lane >> 4;
    for (int i = tid; i < 2 * 64 * 72 / 2; i += NTHR) ((LAS unsigned*)(lds + L_AL))[i] = 0u;
    for (int item = bx; item < 640; item += G) {
        int b, h, slice, row0, nch, T, cid0; const float* S0; float* Sout;
        if (item < 128) { const int seq = item & 15; slice = item >> 4; b = seq >> 3; h = seq & 7; row0 = b * SEQ; nch = SEQ / 64; T = 64; cid0 = b * (SEQ / 64); S0 = nullptr; Sout = out_hp + (size_t)(b * 8 + h) * 16384; }
        else { const int j = item - 128, seq = j & 63; slice = j >> 6; b = seq >> 3; h = seq & 7; row0 = MP + b * DSEQ; nch = 1; T = DSEQ; cid0 = 256 + b; S0 = state_in + (size_t)(b * 8 + h) * 16384; Sout = out_hs + (size_t)(b * 8 + h) * 16384; }
        const int qcol = h * 128, vcol = h * 128 + slice * 16;
        f32x4 S;
#pragma unroll
        for (int i = 0; i < 4; ++i) S[i] = S0 ? S0[(size_t)(16 * wave + 4 * fq + i) * 128 + slice * 16 + fr] : 0.f;
        __syncthreads();
        { u32x2 w; w.x = pk2(S[0], S[1]); w.y = pk2(S[2], S[3]); *(LAS u32x2*)(lds + L_ST + (fr * HP + 16 * wave + 4 * fq) * 2) = w; }
        u32x4 rq[2], rk[2], rv;
        const int prow0 = tid >> 4, pch = tid & 15;
#define HG_LOAD(c) do { _Pragma("unroll") for (int j_ = 0; j_ < 2; ++j_) { const int row_ = prow0 + 32 * j_, rowc_ = row_ < T ? row_ : T - 1; const size_t go_ = (size_t)(row0 + (c) * 64 + rowc_) * DM + qcol + pch * 8; \
            rq[j_] = *(const u32x4*)(Qp + go_); rk[j_] = *(const u32x4*)(Kp + go_); } \
            { const int vrc_ = vrow < T ? vrow : T - 1; rv = *(const u32x4*)(Vb + (size_t)(row0 + (c) * 64 + vrc_) * DM + vcol + vhalf * 8); } \
            egn = *(const f32x4*)(EG + (size_t)(cid0 + (c)) * 1024 + h * 128 + 16 * wave + 4 * fq); } while (0)
#define HG_WRITE(bf) do { LAS unsigned char* qb_ = lds + (bf) * L_QKBUF; _Pragma("unroll") for (int j_ = 0; j_ < 2; ++j_) { const int row_ = prow0 + 32 * j_; const bool z_ = row_ >= T; \
            u32x4 q_ = rq[j_], k_ = rk[j_]; if (z_) { q_ = (u32x4){0u, 0u, 0u, 0u}; k_ = q_; } \
            *(LAS u32x4*)(qb_ + (row_ * HP + pch * 8) * 2) = q_; *(LAS u32x4*)(qb_ + L_KOFF + (row_ * HP + pch * 8) * 2) = k_; } \
            if (tid < 128) { u32x4 v_ = rv; if (vrow >= T) v_ = (u32x4){0u, 0u, 0u, 0u}; LAS unsigned short* vt_ = (LAS unsigned short*)(lds + L_VT + (bf) * L_VTSZ) + (vhalf * 8) * 72 + vrow; \
                vt_[0 * 72] = (unsigned short)v_.x; vt_[1 * 72] = (unsigned short)(v_.x >> 16); vt_[2 * 72] = (unsigned short)v_.y; vt_[3 * 72] = (unsigned short)(v_.y >> 16); \
                vt_[4 * 72] = (unsigned short)v_.z; vt_[5 * 72] = (unsigned short)(v_.z >> 16); vt_[6 * 72] = (unsigned short)v_.w; vt_[7 * 72] = (unsigned short)(v_.w >> 16); } } while (0)
        f32x4 egn, eg;
        const int vrow = (tid & 127) >> 1, vhalf = tid & 1;
        u32x4 rqB[2], rkB[2], rvB; f32x4 egB;
#define CLAMPC(x) ((x) < nch ? (x) : nch - 1)
        HG_LOAD2(0, rq, rk, rv, egn); HG_WRITE2(0, rq, rk, rv); eg = egn;
        HG_LOAD2(CLAMPC(1), rq, rk, rv, egn);
        f32x4 oprev = zero_acc(); bf16x8 vprev0 = (bf16x8){0, 0, 0, 0, 0, 0, 0, 0}, vprev1 = vprev0;
        for (int c = 0; c <= nch; c += 2) {
            HG_LOAD2(CLAMPC(c + 2), rqB, rkB, rvB, egB);
            __syncthreads();
            HG_STEP(c);
            HG_WRITE2(1, rq, rk, rv); eg = egn;
            if (c + 1 > nch) break;
            HG_LOAD2(CLAMPC(c + 3), rq, rk, rv, egn);
            __syncthreads();
            HG_STEP(c + 1);
            HG_WRITE2(0, rqB, rkB, rvB); eg = egB;
        }
#undef CLAMPC
#pragma unroll
        for (int i = 0; i < 4; ++i) Sout[(size_t)(16 * wave + 4 * fq + i) * 128 + slice * 16 + fr] = S[i];
#undef HG_LOAD
#undef HG_WRITE
    }
}

__device__ __forceinline__ void prep_og(const bf16_t* Ob, bf16_t* OG, const float* gn, int gw, int NGW, int lane) {
    for (int m = gw; m < M; m += NGW) {
#pragma unroll
        for (int j = 0; j < 2; ++j) {
            const int col = lane * 8 + 512 * j;
            f32x4 o0, o1, g0, g1; unpack8(*(const u32x4*)(Ob + (size_t)m * DM + col), o0, o1); unpack8(*(const u32x4*)(OG + (size_t)m * DM + col), g0, g1);
            float ssq = (o0.x * o0.x + o0.y * o0.y) + (o0.z * o0.z + o0.w * o0.w) + (o1.x * o1.x + o1.y * o1.y) + (o1.z * o1.z + o1.w * o1.w);
            ssq += __shfl_xor(ssq, 1); ssq += __shfl_xor(ssq, 2); ssq += __shfl_xor(ssq, 4); ssq += __shfl_xor(ssq, 8);
            const float rs = rsqrtf(ssq * (1.f / 128.f) + EPS);
            const f32x4 n0 = *(const f32x4*)(gn + (col & 127)), n1 = *(const f32x4*)(gn + (col & 127) + 4);
            *(u32x4*)(OG + (size_t)m * DM + col) = pack8(o0 * n0 * g0 * rs, o1 * n1 * g1 * rs);
        }
    }
}
__device__ __forceinline__ void pool_row(const bf16_t* Ub, bf16_t* POOLED, const float* state_pool, float* out_pp, float* out_ps, int m, int lane) {
    int t, pos, TL; const float* buf; float* po;
    if (m < MP) { const int b = m / SEQ; t = m % SEQ; pos = t; TL = SEQ; buf = nullptr; po = out_pp + (size_t)b * 15 * 512; }
    else { const int b = (m - MP) / DSEQ; t = (m - MP) % DSEQ; pos = PAST + t; TL = DSEQ; buf = state_pool + (size_t)b * 15 * 512; po = out_ps + (size_t)b * 15 * 512; }
    const int col = lane * 8, w = 2 << (lane >> 4);
    f32x4 s0 = (f32x4){0.f, 0.f, 0.f, 0.f}, s1 = s0, u0 = s0, u1 = s0;
    for (int jj = 0; jj < w; ++jj) {
        const int tt = t - jj; f32x4 a0, a1;
        if (tt >= 0) unpack8(*(const u32x4*)(Ub + (size_t)(m - jj) * BW + col), a0, a1);
        else if (buf) { a0 = *(const f32x4*)(buf + (size_t)(15 + tt) * 512 + col); a1 = *(const f32x4*)(buf + (size_t)(15 + tt) * 512 + col + 4); }
        else { a0 = (f32x4){0.f, 0.f, 0.f, 0.f}; a1 = a0; }
        if (jj == 0) { u0 = a0; u1 = a1; }
        s0 = s0 + a0; s1 = s1 + a1;
    }
    const float ic = 1.0f / (float)((pos + 1 < w) ? pos + 1 : w);
    *(u32x4*)(POOLED + (size_t)m * BW + col) = pack8(s0 * ic - u0, s1 * ic - u1);
    if (t >= TL - 15) { float* p = po + (size_t)(t - (TL - 15)) * 512 + col; *(f32x4*)p = u0; *(f32x4*)(p + 4) = u1; }
}
__device__ __forceinline__ void prep_pool(const bf16_t* Ub, bf16_t* POOLED, const float* state_pool, float* out_pp, float* out_ps, int gw, int NGW, int lane) {
    const int col = lane * 8, w = 2 << (lane >> 4); const float ic = 1.0f / (float)w;
    for (int m0 = gw; m0 < M; m0 += 2 * NGW) {
        const int m1 = m0 + NGW; const bool two = m1 < M;
        const int t0 = (m0 < MP) ? m0 % SEQ : (m0 - MP) % DSEQ, t1 = two ? ((m1 < MP) ? m1 % SEQ : (m1 - MP) % DSEQ) : 0;
        if (two && t0 >= 15 && t1 >= 15) {
            u32x4 r0[16], r1[16];
#pragma unroll
            for (int jj = 0; jj < 16; ++jj) { r0[jj] = (u32x4){0u, 0u, 0u, 0u}; r1[jj] = r0[jj];
                if (jj < w) { r0[jj] = *(const u32x4*)(Ub + (size_t)(m0 - jj) * BW + col); r1[jj] = *(const u32x4*)(Ub + (size_t)(m1 - jj) * BW + col); } }
#pragma unroll
            for (int h = 0; h < 2; ++h) {
                const int m = h ? m1 : m0, t = h ? t1 : t0;
                f32x4 s0 = (f32x4){0.f, 0.f, 0.f, 0.f}, s1 = s0, u0 = s0, u1 = s0;
#pragma unroll
                for (int jj = 0; jj < 16; ++jj) { f32x4 a0, a1; unpack8(h ? r1[jj] : r0[jj], a0, a1); s0 = s0 + a0; s1 = s1 + a1; if (jj == 0) { u0 = a0; u1 = a1; } }
                *(u32x4*)(POOLED + (size_t)m * BW + col) = pack8(s0 * ic - u0, s1 * ic - u1);
                const int TL = (m < MP) ? SEQ : DSEQ;
                if (t >= TL - 15) { float* po = (m < MP) ? out_pp + (size_t)(m / SEQ) * 15 * 512 : out_ps + (size_t)((m - MP) / DSEQ) * 15 * 512;
                    float* p = po + (size_t)(t - (TL - 15)) * 512 + col; *(f32x4*)p = u0; *(f32x4*)(p + 4) = u1; }
            }
        } else { pool_row(Ub, POOLED, state_pool, out_pp, out_ps, m0, lane); if (two) pool_row(Ub, POOLED, state_pool, out_pp, out_ps, m1, lane); }
    }
}

typedef __attribute__((address_space(1))) unsigned gu32;
#define XB_TMO      128
#define XB_XCNT(j)  (256  + 64 * (j))
#define XB_XSUB(j)  (1280 + 64 * (j))
#define XB_XGEN(j)  (2304 + 64 * (j))
#define XB_TOP      3328
#define XB_TOPGEN   3392
#define XCD_BAR_WORDS 3456
#define XB_SPIN_CAP (1u << 18)

__device__ __forceinline__ unsigned xb_ld(unsigned* p)              { return __hip_atomic_load(p, __ATOMIC_RELAXED, __HIP_MEMORY_SCOPE_AGENT); }
__device__ __forceinline__ unsigned xb_add(unsigned* p, unsigned v) { return __hip_atomic_fetch_add(p, v, __ATOMIC_RELAXED, __HIP_MEMORY_SCOPE_AGENT); }
__device__ __forceinline__ unsigned xb_xcc_id() { return (unsigned)__builtin_amdgcn_s_getreg((3 << 11) | 20) & 0xFu; }
#define XB_SPIN(cond, bar) do { unsigned _sp = 0; while (cond) { __builtin_amdgcn_s_sleep(1); \
    if ((++_sp & 255u) == 0u) { if (xb_ld(&(bar)[XB_TMO])) break; if (_sp > XB_SPIN_CAP) { atomicAdd(&(bar)[XB_TMO], 1u); break; } } } } while (0)

struct XcdBarrier {
    unsigned* bar; unsigned x;
    volatile LAS unsigned* st;
};

__device__ __forceinline__ XcdBarrier xcd_barrier_post(unsigned* bar, volatile LAS unsigned* st) {
    XcdBarrier b; b.bar = bar; b.x = xb_xcc_id(); b.st = st;
    if (threadIdx.x == 0) (void)xb_add(&bar[XB_XCNT(b.x)], 1u);
    return b;
}
__device__ __forceinline__ void xcd_barrier_complete(unsigned* bar, unsigned x, unsigned& nloc, unsigned& nx) {
    const unsigned G = gridDim.x * gridDim.y * gridDim.z;
    unsigned sum, cnt, mine, sp = 0u;
    for (;;) {
        sum = 0u; cnt = 0u; mine = 0u;
#pragma unroll
        for (unsigned j = 0; j < 16; ++j) { const unsigned c = xb_ld(&bar[XB_XCNT(j)]); sum += c; cnt += (c > 0u) ? 1u : 0u; mine = (j == x) ? c : mine; }
        if (sum == G) break;
        __builtin_amdgcn_s_sleep(1);
        if ((++sp & 255u) == 0u) { if (xb_ld(&bar[XB_TMO])) break; if (sp > XB_SPIN_CAP) { atomicAdd(&bar[XB_TMO], 1u); break; } }
    }
    nloc = mine > 0u ? mine : 1u; nx = cnt > 0u ? cnt : 1u;
}

__device__ __forceinline__ void xcd_barrier(const XcdBarrier& b) {
    asm volatile("s_waitcnt vmcnt(0)" ::: "memory");
    __syncthreads();
    if (threadIdx.x == 0) {
        unsigned* bar = b.bar;
        __builtin_amdgcn_s_waitcnt(0);
        unsigned nloc = b.st[0], nx = b.st[1];
        if (nloc == 0u) { xcd_barrier_complete(bar, b.x, nloc, nx); b.st[0] = nloc; b.st[1] = nx; }
        const unsigned old = xb_add(&bar[XB_XSUB(b.x)], 1u);
        const unsigned gen = old / nloc;
        if (old + 1u == (gen + 1u) * nloc) {
            __builtin_amdgcn_fence(__ATOMIC_RELEASE, "agent");
            asm volatile("s_waitcnt vmcnt(0)" ::: "memory");
            const unsigned og = xb_add(&bar[XB_TOP], 1u);
            const unsigned tg = og / nx;
            if (og + 1u == (tg + 1u) * nx) xb_add(&bar[XB_TOPGEN], 1u);
            else XB_SPIN(xb_ld(&bar[XB_TOPGEN]) == tg, bar);
            __builtin_amdgcn_fence(__ATOMIC_ACQUIRE, "agent");
            xb_add(&bar[XB_XGEN(b.x)], 1u);
            asm volatile("s_waitcnt vmcnt(0)" ::: "memory");
        } else {
            XB_SPIN(xb_ld(&bar[XB_XGEN(b.x)]) == gen, bar);
            __builtin_amdgcn_fence(__ATOMIC_ACQUIRE, "agent");
            asm volatile("s_waitcnt vmcnt(0)" ::: "memory");
        }
    }
    __syncthreads();
}

struct Args { const float* in[21]; float* out; unsigned char* ws; };
enum { I_XP = 0, I_XS, I_PP, I_PS, I_SH, I_SP, I_GAINS, I_LB, I_GU1, I_D1, I_WIN, I_GN, I_WA, I_WPOOL, I_PSCALE, I_WB, I_WOUT, I_GU2, I_D2, I_WPP, I_WPG };

__global__ void __launch_bounds__(NTHR, 2) mega_fwd(Args a) {
    extern __shared__ __attribute__((aligned(16))) unsigned char lds_raw[];
    LAS unsigned char* lds = (LAS unsigned char*)lds_raw;
    cg::grid_group grid = cg::this_grid();
    const int tid = threadIdx.x, lane = tid & 63, wave = __builtin_amdgcn_readfirstlane(tid >> 6);
    const int G = gridDim.x, bx = blockIdx.x, vcu = (G % 8 == 0) ? (bx % 8) * (G / 8) + bx / 8 : bx;
    const int gw = vcu * NWAVES + wave, NGW = G * NWAVES;
    unsigned char* ws = a.ws; float* out = a.out;
    float* LB = (float*)(ws + WS_LB); float* EG = (float*)(ws + WS_EG);
    bf16_t* H = (bf16_t*)(ws + WS_H); bf16_t* Y = (bf16_t*)(ws + WS_Y); bf16_t* ACT = (bf16_t*)(ws + B_ACT);
    bf16_t *Qp = (bf16_t*)(ws + B_QP), *Kp = (bf16_t*)(ws + B_KP), *Vb = (bf16_t*)(ws + B_VB), *OG = (bf16_t*)(ws + B_OG), *Ob = (bf16_t*)(ws + B_O), *GA = (bf16_t*)(ws + B_GA), *GB = (bf16_t*)(ws + B_GB);
    bf16_t *Ub = (bf16_t*)(ws + WS_U), *POOLED = (bf16_t*)(ws + WS_POOLED), *PM = (bf16_t*)(ws + WS_PM), *Eb = (bf16_t*)(ws + B_E), *Pb = (bf16_t*)(ws + B_PB);
    const float* gains = a.in[I_GAINS];
    { volatile LAS unsigned* st0 = (volatile LAS unsigned*)(lds + 131072 + 256); if (tid < 2) st0[tid] = 0u; }
    __syncthreads();
    XcdBarrier xbar = xcd_barrier_post((unsigned*)(ws + WS_SS), (volatile LAS unsigned*)(lds + 131072 + 256));
    grid.sync();
#define GSYNC() xcd_barrier(xbar)
#define WT(off) ((bf16_t*)(ws + (off)))
    constexpr int NI_GU = 16 * 176, NI_D = 44 * 32, NI_IN = 16 * 208, NI_SQ = 16 * 32, NI_B = 8 * 32, NI_PP = 4 * 32;
    constexpr int NI_EARLY = NI_GU + NI_D + NI_IN, NITEMS = 2 * NI_GU + 2 * NI_D + NI_IN + 3 * NI_SQ + NI_B + NI_PP;
    constexpr int IT_D2 = NI_EARLY + NI_GU, IT_A = IT_D2 + NI_D, IT_PG = IT_A + 2 * NI_SQ, IT_B = IT_PG + NI_SQ, IT_PP = IT_B + NI_B;
#define CONVERT_ITEMS(lo_, hi_, gw_, ngw_) do { LAS float* scr_ = (LAS float*)(lds + wave * 16384); const int lane_ = otid() & 63; \
        for (int it = (lo_) + (gw_); it < (hi_); it += (ngw_)) { int r = it; const float* W; int K, N, kind = 0; bf16_t* dst; \
            if (r < NI_GU) { W = a.in[I_GU1]; K = 1024; N = 5632; dst = WT(W_GU1); kind = 1; } \
            else if ((r -= NI_GU) < NI_D) { W = a.in[I_D1]; K = 2816; N = 1024; dst = WT(W_D1); } \
            else if ((r -= NI_D) < NI_IN) { W = a.in[I_WIN]; K = 1024; N = 6656; dst = WT(W_IN); kind = 2; } \
            else if ((r -= NI_IN) < NI_GU) { W = a.in[I_GU2]; K = 1024; N = 5632; dst = WT(W_GU2); kind = 1; } \
            else if ((r -= NI_GU) < NI_D) { W = a.in[I_D2]; K = 2816; N = 1024; dst = WT(W_D2); } \
            else if ((r -= NI_D) < NI_SQ) { W = a.in[I_WA]; K = 1024; N = 1024; dst = WT(W_A); } \
            else if ((r -= NI_SQ) < NI_SQ) { W = a.in[I_WOUT]; K = 1024; N = 1024; dst = WT(W_OUT); } \
            else if ((r -= NI_SQ) < NI_SQ) { W = a.in[I_WPG]; K = 1024; N = 1024; dst = WT(W_PG); } \
            else if ((r -= NI_SQ) < NI_B) { W = a.in[I_WB]; K = 512; N = 1024; dst = WT(W_B); } \
            else { r -= NI_B; W = a.in[I_WPP]; K = 256; N = 1024; dst = WT(W_PP); } \
            const int nblk = N / 32, kb = r / nblk, nb = r % nblk, dn = nb * 32; \
            const int sn = kind == 1 ? map_gu(dn) : (kind == 2 ? map_in(dn) : dn); \
            transpose_item(W, N, sn, K, dst, dn, kb * 64, scr_, lane_); } } while (0)
#define SGW bx, G, wave, otid() & 63
#define GEMM(EpiT, E, Aptr, Btptr, N_, K_, nNp, pn0p, nNs, pn0s, rot) do { pg8::Gemm g_{(Aptr), (Btptr), M, (N_), (K_)}; TileSched S_; S_.init((nNp), (pn0p), (nNs), (pn0s), G, (bx + (rot)) % G); \
        pg8::gemm_phase<EpiT, TileSched, true, true>(lds, g_, S_, (E)); } while (0)

    {
        CONVERT_ITEMS(0, (G == 256) ? NI_GU : NI_EARLY, gw, NGW);
        const int gt = bx * NTHR + tid, NGT = G * NTHR;
        { const float* wp = a.in[I_WPOOL]; bf16_t* d = WT(W_POOL);
          for (int idx = gt; idx < 512 * 512 / 2; idx += NGT) { const int n = idx >> 8, k = (idx & 255) * 2, g1 = n >> 7, dd = n & 127, g2 = k >> 7, c = k & 127;
              float v0 = 0.f, v1 = 0.f; if (g1 == g2) { v0 = wp[(size_t)(g1 * 128 + c) * 128 + dd]; v1 = wp[(size_t)(g1 * 128 + c + 1) * 128 + dd]; }
              ((unsigned*)d)[idx] = pk2(v0, v1); } }
        for (int idx = gt; idx < 1024; idx += NGT) { const float l0 = a.in[I_LB][idx], l1 = a.in[I_LB][1024 + idx]; LB[idx] = 1.0f / (1.0f + __expf(l1 - l0)); }
        for (int m = gw; m < M; m += NGW) { const float* xr = (m < MP) ? a.in[I_XP] + (size_t)m * DM : a.in[I_XS] + (size_t)(m - MP) * DM; rms_row_to_bf16(xr, gains + 0 * DM, H + (size_t)m * DM, lane); }
    }
    GSYNC();
    { EpiSwiGLU E{ACT}; GEMM(EpiSwiGLU, E, H, WT(W_GU1), 5632, 1024, 22, 0, 22, 0, 0); }
    if (G == 256 && bx >= 150) {
        __syncthreads(); CONVERT_ITEMS(NI_GU, NI_EARLY, (bx - 150) * NWAVES + wave, 106 * NWAVES); }
    GSYNC();
    { EpiStore<false> E{Y, DM, nullptr}; GEMM(EpiStore<false>, E, ACT, WT(W_D1), 1024, DFF, 4, 0, 0, 0, 0); SStore ES{Y, DM, nullptr}; sgemm_sample(lds, ACT, WT(W_D1), 1024, DFF, ES, SGW);
    }
    GSYNC();
    row_phase<true>(Y, a.in[I_XP], a.in[I_XS], out + O_Y, H, gains + 1 * DM, 0.5f, gains + 2 * DM, gw, NGW, otid() & 63);
    GSYNC();
    { EpiIn E{ws, EG, LB}; GEMM(EpiIn, E, H, WT(W_IN), NIN, 1024, 14, 0, 26, 0, 0); }
    if (G == 256 && bx >= 154) {
        __syncthreads(); const int gw4 = (bx - 154) * NWAVES + wave;
        CONVERT_ITEMS(IT_A, IT_PG, gw4, 102 * NWAVES); CONVERT_ITEMS(IT_B, IT_PP, gw4, 102 * NWAVES);
        CONVERT_ITEMS(NI_EARLY, NI_EARLY + NI_GU, gw4, 102 * NWAVES); }
    GSYNC();
    hgrn_phase(lds, Qp, Kp, Vb, Ob, EG, a.in[I_SH], out + O_HP, out + O_HS, G, bx, otid());
    { const int half = (G >= 256) ? 128 : 0;
      if (bx >= half) { __syncthreads(); const int gw2 = (bx - half) * NWAVES + wave, ngw2 = (G - half) * NWAVES;
          if (G == 256) { CONVERT_ITEMS(IT_D2, IT_A, gw2, ngw2); CONVERT_ITEMS(IT_PG, IT_B, gw2, ngw2); CONVERT_ITEMS(IT_PP, NITEMS, gw2, ngw2); }
          else CONVERT_ITEMS(NI_EARLY, NITEMS, gw2, ngw2);
          prep_pool(Ub, POOLED, a.in[I_SP], out + O_PP, out + O_PS, gw2, ngw2, otid() & 63);
          asm volatile("s_waitcnt vmcnt(0)" ::: "memory"); __syncthreads();
          if (otid() == 0) { __builtin_amdgcn_fence(__ATOMIC_RELEASE, "agent"); asm volatile("s_waitcnt vmcnt(0)" ::: "memory");
              unsigned* cnt = (unsigned*)(ws + 14336); __hip_atomic_fetch_add(cnt, 1u, __ATOMIC_RELAXED, __HIP_MEMORY_SCOPE_AGENT);
              unsigned sp = 0; while (__hip_atomic_load(cnt, __ATOMIC_RELAXED, __HIP_MEMORY_SCOPE_AGENT) < (unsigned)(G - half)) { __builtin_amdgcn_s_sleep(2); if (++sp > (1u << 22)) break; }
              __builtin_amdgcn_fence(__ATOMIC_ACQUIRE, "agent"); asm volatile("s_waitcnt vmcnt(0)" ::: "memory"); }
          __syncthreads();
          { EpiStore<true> E{PM, BW, a.in[I_PSCALE]}; pg8::Gemm g_{POOLED, WT(W_POOL), M, 512, 512}; TileSched S_; S_.init(2, 0, 0, 0, G - half, bx - half);
            pg8::gemm_phase<EpiStore<true>, TileSched, true, true>(lds, g_, S_, E);
            SStore ES{PM, BW, a.in[I_PSCALE]}; sgemm_sample(lds, POOLED, WT(W_POOL), 512, 512, ES, bx - half, G - half, wave, otid() & 63); }
          __syncthreads();
          { EpiIn E{ws, EG, LB}; pg8::Gemm g_{H, WT(W_IN), M, NIN, 1024}; TileSched S_; S_.init(4, 14, 0, 0, G - half, bx - half);
            pg8::gemm_phase<EpiIn, TileSched, true, true>(lds, g_, S_, E); } } }
    GSYNC();
    if (bx & 1) prep_og(Ob, OG, a.in[I_GN], gw, NGW, otid() & 63);
    { EpiIn E{ws, EG, LB}; GEMM(EpiIn, E, H, WT(W_IN), NIN, 1024, 8, 18, 0, 0, 0); }
    if (!(bx & 1)) prep_og(Ob, OG, a.in[I_GN], gw, NGW, otid() & 63);
    GSYNC();
    {
        { EpiMulInPlace E{GA}; GEMM(EpiMulInPlace, E, OG, WT(W_A), 1024, 1024, 4, 0, 0, 0, 0); SMulInPlace ES{GA}; sgemm_sample(lds, OG, WT(W_A), 1024, 1024, ES, SGW); }
        { EpiFmaInPlace E{GA, GB}; GEMM(EpiFmaInPlace, E, PM, WT(W_B), 1024, 512, 4, 0, 0, 0, 0); SFmaInPlace ES{GA, GB}; sgemm_sample(lds, PM, WT(W_B), 1024, 512, ES, SGW); }
    }
    GSYNC();
    { EpiStore<false> E{Y, DM, nullptr};
      GEMM(EpiStore<false>, E, GB, WT(W_OUT), 1024, 1024, 4, 0, 0, 0, 0); { SStore ES{Y, DM, nullptr}; sgemm_sample(lds, GB, WT(W_OUT), 1024, 1024, ES, SGW); }
    }
    GSYNC();
    row_phase<true>(Y, out + O_Y, out + O_Y + (size_t)MP * DM, out + O_Y, H, gains + 3 * DM, 1.0f, gains + 4 * DM, gw, NGW, otid() & 63);
    GSYNC();
    { EpiSwiGLU E{ACT}; GEMM(EpiSwiGLU, E, H, WT(W_GU2), 5632, 1024, 22, 0, 22, 0, 0); }
    { const int first = (G == 256) ? 150 : 0;
      if (bx >= first) { const int gt = (bx - first) * NTHR + otid(), NGT = (G - first) * NTHR;
        for (int idx = gt; idx < M * PLE / 4; idx += NGT) { const int e = idx * 4; const float* src = (e < MP * PLE) ? a.in[I_PP] + e : a.in[I_PS] + (e - MP * PLE); const f32x4 v = *(const f32x4*)src;
            u32x2 w; w.x = pk2(v.x, v.y); w.y = pk2(v.z, v.w); ((u32x2*)Pb)[idx] = w; } } }
    GSYNC();
    { EpiStore<false> E{Y, DM, nullptr}; GEMM(EpiStore<false>, E, ACT, WT(W_D2), 1024, DFF, 4, 0, 0, 0, 0); SStore ES{Y, DM, nullptr}; sgemm_sample(lds, ACT, WT(W_D2), 1024, DFF, ES, SGW); }
    GSYNC();
    row_phase<true>(Y, out + O_Y, out + O_Y + (size_t)MP * DM, out + O_Y, H, gains + 5 * DM, 0.5f, gains + 6 * DM, gw, NGW, otid() & 63);
    GSYNC();
    { EpiStore<false> E{Eb, DM, nullptr}; GEMM(EpiStore<false>, E, Pb, WT(W_PP), 1024, PLE, 4, 0, 0, 0, 0); SStore ES{Eb, DM, nullptr}; sgemm_sample(lds, Pb, WT(W_PP), 1024, PLE, ES, SGW); }
    { EpiPleGate E{Eb, Y}; GEMM(EpiPleGate, E, H, WT(W_PG), 1024, 1024, 4, 0, 0, 0, 0); SPleGate ES{Eb, Y}; sgemm_sample(lds, H, WT(W_PG), 1024, 1024, ES, SGW); }
    GSYNC();
    row_phase<false>(Y, out + O_Y, out + O_Y + (size_t)MP * DM, out + O_Y, nullptr, gains + 7 * DM, 1.0f, nullptr, gw, NGW, otid() & 63);
#undef WT
#undef GEMM
}

extern "C" void kernel_launch(void* const* d_in, const int* in_sizes, int n_in, void* d_out, int out_size, void* d_ws, size_t ws_size, hipStream_t stream) {
    static int grid = 0;
    if (grid == 0) {
        if (n_in != 21 || in_sizes[0] != MP * DM || ws_size < WS_NEED) { fprintf(stderr, "kernel_launch: unexpected shapes (n_in %d, ws %zu, need %zu)\n", n_in, ws_size, (size_t)WS_NEED); grid = -1; return; }
        int dev = 0, cus = 0, per_cu = 0;
        hipGetDevice(&dev); hipDeviceGetAttribute(&cus, hipDeviceAttributeMultiprocessorCount, dev);
        hipFuncSetAttribute((const void*)mega_fwd, hipFuncAttributeMaxDynamicSharedMemorySize, LDS_BYTES);
        hipOccupancyMaxActiveBlocksPerMultiprocessor(&per_cu, (const void*)mega_fwd, NTHR, LDS_BYTES);
        if (per_cu < 1) { fprintf(stderr, "kernel_launch: occupancy query says %d blocks/CU\n", per_cu); per_cu = 1; }
        grid = cus;
        if (grid > 256) grid = 256;
        grid &= ~7;
    }
    if (grid <= 0) return;
    Args a{};
    for (int i = 0; i < 21; ++i) a.in[i] = (const float*)d_in[i];
    a.out = (float*)d_out; a.ws = (unsigned char*)d_ws;
    if (hipMemsetAsync(d_ws, 0, 16384, stream) != hipSuccess) { fprintf(stderr, "kernel_launch: memset failed\n"); return; }
    void* args[] = {&a};
    hipError_t e = hipLaunchCooperativeKernel((const void*)mega_fwd, dim3(grid), dim3(NTHR), args, LDS_BYTES, stream);
    if (e != hipSuccess) fprintf(stderr, "kernel_launch: cooperative launch failed: %s (grid %d)\n", hipGetErrorString(e), grid);
}
```

```cpp
#include <hip/hip_runtime.h>
#include <hip/hip_cooperative_groups.h>
#include <cstdio>
#include <cstdint>
namespace cg = cooperative_groups;
namespace pg8 {
#define PG8_LAS __attribute__((address_space(3)))
typedef unsigned short bf16_t;
typedef short bf16x8 __attribute__((ext_vector_type(8)));
typedef float f32x4 __attribute__((ext_vector_type(4)));
typedef unsigned u32x4 __attribute__((ext_vector_type(4)));
constexpr int BM = 256, BK = 64, HALF = 128, HTB = HALF * BK * 2  , STAGE_BYTES = 8 * HTB, NXCD = 8, WGM = 8;

__host__ __device__ __forceinline__ int lds_byte(int r, int c) { const int st = (r >> 4) * 2 + (c >> 5), rr = r & 15, cc = c & 31, ob = rr * 64 + cc * 2; return st * 1024 + (ob ^ (((ob >> 9) & 1) << 5)); }
__host__ __device__ __forceinline__ void stage_rc(int b, int& R, int& C) { const int st = b / 1024, sb = b % 1024, swz = sb ^ (((sb >> 9) & 1) << 5); R = (st >> 1) * 16 + swz / 64; C = (st & 1) * 32 + (swz % 64) / 2; }
__host__ __device__ __forceinline__ int perm32(int rho) { const int n = rho >> 4, i = rho & 15; return 8 * (i >> 2) + 4 * n + (i & 3); }

struct Unit { int pm, pn; };
struct Gemm { const bf16_t* A; const bf16_t* Bt; int M, N, K; };

struct StaticOrder {
    int nM, nN, nwg, G, c;
    __host__ __device__ void init(int M, int N, int G_, int c_) { nM = M / BM; nN = N / BM; nwg = nM * nN; G = G_; c = c_; }
    __host__ __device__ bool next(int i, Unit& u) const {
        const long L = (long)i * G + c; if (L >= nwg) return false;
        int wgid = (int)L; { const int q = nwg / NXCD, r = nwg % NXCD, xcd = wgid % NXCD, off = wgid / NXCD; wgid = (xcd < r ? xcd * (q + 1) : r * (q + 1) + (xcd - r) * q) + off; }
        const int nig = WGM * nN, gid = wgid / nig, fm = gid * WGM, gsz = (nM - fm) < WGM ? (nM - fm) : WGM;
        u.pm = fm + ((wgid % nig) % gsz); u.pn = (wgid % nig) / gsz; return true;
    }
    __device__ __forceinline__ void a_ready(const Unit&) const {}
    __device__ __forceinline__ void done(const Unit&) const {}
};

__device__ __forceinline__ unsigned cvt_pk_bf16(float lo, float hi) { unsigned r; asm volatile("v_cvt_pk_bf16_f32 %0, %1, %2" : "=v"(r) : "v"(lo), "v"(hi)); return r; }
typedef float f32x2 __attribute__((ext_vector_type(2)));
template <class Epi, class Sched, bool ALIGN_EPI = false, bool SP2 = false>
__device__ __forceinline__ void gemm_phase(PG8_LAS unsigned char* lds, const Gemm g, const Sched& S, const Epi& E) {
    int tid_ = threadIdx.x; asm volatile("" : "+v"(tid_));
    const int tid = tid_, wid = __builtin_amdgcn_readfirstlane(tid >> 6), lane = tid & 63, wr = wid >> 2, wc = wid & 3, fr = lane & 15, fq = lane >> 4;
    const int K = g.K, nt = K / BK;
    unsigned voffA[2], voffB[2];
#pragma unroll
    for (int i = 0; i < 2; ++i) { int R, C; stage_rc(tid * 16 + i * 8192, R, C); const int Rb = Epi::PERM ? ((R & ~31) + perm32(R & 31)) : R;
        voffA[i] = (unsigned)(R * K + C) * 2u; voffB[i] = (unsigned)(Rb * K + C) * 2u; }
    const size_t kstep = (size_t)(BK * 2);
    const size_t hstep = (size_t)HALF * K * 2;
    const size_t tstep = 2 * hstep;
    const unsigned ldsw = (unsigned)wid * 1024u;
    const int aoff = lds_byte(wr * 64 + fr, fq * 8), boff = lds_byte(wc * 32 + fr, fq * 8);
#define PG8_SA(b, h) (((b) * 2 + (h)) * HTB)
#define PG8_SB(b, h) ((4 + (b) * 2 + (h)) * HTB)
#define PG8_STAGE(bufoff, gbase, voff) do { _Pragma("unroll") for (int _i = 0; _i < 2; ++_i) \
        __builtin_amdgcn_global_load_lds((const unsigned*)((const char*)(gbase) + (voff)[_i]), (PG8_LAS unsigned*)(lds + (bufoff) + ldsw + _i * 8192), 16, 0, 0); } while (0)
#define PG8_LDA(dst, b, h) do { _Pragma("unroll") for (int m = 0; m < 4; ++m) _Pragma("unroll") for (int k = 0; k < 2; ++k) dst[m][k] = *(const PG8_LAS bf16x8*)(lds + PG8_SA(b, h) + aoff + m * 2048 + k * 1024); } while (0)
#define PG8_LDB(dst, b, h) do { _Pragma("unroll") for (int n = 0; n < 2; ++n) _Pragma("unroll") for (int k = 0; k < 2; ++k) dst[n][k] = *(const PG8_LAS bf16x8*)(lds + PG8_SB(b, h) + boff + n * 2048 + k * 1024); } while (0)
#define PG8_MMA(ai, bj, At, Bt) do { __builtin_amdgcn_s_setprio(1); _Pragma("unroll") for (int m = 0; m < 4; ++m) _Pragma("unroll") for (int n = 0; n < 2; ++n) _Pragma("unroll") for (int k = 0; k < 2; ++k) \
        acc[ai][bj][m][n] = __builtin_amdgcn_mfma_f32_16x16x32_bf16(Bt[n][k], At[m][k], acc[ai][bj][m][n], 0, 0, 0); __builtin_amdgcn_s_setprio(0); } while (0)
#define PG8_WAIT_V(n) asm volatile("s_waitcnt vmcnt(" #n ")" ::: "memory")
#define PG8_WAIT_L(n) asm volatile("s_waitcnt lgkmcnt(" #n ")" ::: "memory")
#define PG8_BAR __builtin_amdgcn_s_barrier()
#define PG8_SCHED __builtin_amdgcn_sched_barrier(0)
    Unit cur, nxt; int ui = 0;
    if (!S.next(0, cur)) return;
    f32x4 acc[2][2][4][2];
#pragma unroll
    for (int a = 0; a < 2; ++a)
#pragma unroll
        for (int b = 0; b < 2; ++b)
#pragma unroll
            for (int m = 0; m < 4; ++m)
#pragma unroll
                for (int n = 0; n < 2; ++n) acc[a][b][m][n] = (f32x4){0.f, 0.f, 0.f, 0.f};
    bf16x8 At[4][2], B0[2][2], B1[2][2];
    const char* cA = (const char*)g.A + (size_t)cur.pm * tstep; const char* cB = (const char*)g.Bt + (size_t)cur.pn * tstep;
    S.a_ready(cur);
    if constexpr (SP2) {
        PG8_STAGE(PG8_SB(0, 0), cB, voffB); PG8_STAGE(PG8_SB(0, 1), cB + hstep, voffB); PG8_STAGE(PG8_SA(0, 0), cA, voffA); PG8_STAGE(PG8_SA(0, 1), cA + hstep, voffA);
        if (wr == 1) PG8_BAR;
        PG8_WAIT_V(2); PG8_BAR;
        PG8_STAGE(PG8_SB(1, 0), cB + kstep, voffB); PG8_STAGE(PG8_SA(1, 0), cA + kstep, voffA); PG8_STAGE(PG8_SB(1, 1), cB + hstep + kstep, voffB);
        PG8_WAIT_V(6); PG8_BAR;
    } else {
        PG8_STAGE(PG8_SB(0, 0), cB, voffB); PG8_STAGE(PG8_SA(0, 0), cA, voffA); PG8_STAGE(PG8_SB(0, 1), cB + hstep, voffB); PG8_STAGE(PG8_SA(0, 1), cA + hstep, voffA);
        if (wr == 1) PG8_BAR;
        PG8_WAIT_V(4); PG8_BAR;
        PG8_STAGE(PG8_SB(1, 0), cB + kstep, voffB); PG8_STAGE(PG8_SA(1, 0), cA + kstep, voffA); PG8_STAGE(PG8_SB(1, 1), cB + hstep + kstep, voffB);
        PG8_WAIT_V(6); PG8_BAR;
    }
    for (;;) {
        const bool has_next = S.next(ui + 1, nxt);
        const char* nA = has_next ? (const char*)g.A + (size_t)nxt.pm * tstep : cA; const char* nB = has_next ? (const char*)g.Bt + (size_t)nxt.pn * tstep : cB;
        for (int t = 0; t < nt; t += 2) {
            const bool last = (t == nt - 2);
            const char* a1 = cA + (size_t)(t + 1) * kstep;
            const char* a2 = last ? nA : cA + (size_t)(t + 2) * kstep; const char* b2 = last ? nB : cB + (size_t)(t + 2) * kstep;
            const char* a3 = a2 + kstep; const char* b3 = b2 + kstep;
            if (last && has_next) S.a_ready(nxt);
            if constexpr (SP2) {
            PG8_LDB(B0, 0, 0); PG8_LDB(B1, 0, 1); PG8_SCHED; PG8_LDA(At, 0, 0); PG8_STAGE(PG8_SA(1, 1), a1 + hstep, voffA);
            PG8_WAIT_V(8); PG8_WAIT_L(0); PG8_BAR; PG8_MMA(0, 0, At, B0); PG8_MMA(0, 1, At, B1); PG8_BAR; PG8_SCHED;
            PG8_LDA(At, 0, 1); PG8_STAGE(PG8_SB(0, 0), b2, voffB); PG8_STAGE(PG8_SB(0, 1), b2 + hstep, voffB); PG8_STAGE(PG8_SA(0, 0), a2, voffA);
            PG8_WAIT_V(8); PG8_WAIT_L(0); PG8_BAR; PG8_MMA(1, 0, At, B0); PG8_MMA(1, 1, At, B1); PG8_BAR; PG8_SCHED;
            PG8_LDB(B0, 1, 0); PG8_LDB(B1, 1, 1); PG8_SCHED; PG8_LDA(At, 1, 0); PG8_STAGE(PG8_SA(0, 1), a2 + hstep, voffA);
            PG8_WAIT_V(8); PG8_WAIT_L(0); PG8_BAR; PG8_MMA(0, 0, At, B0); PG8_MMA(0, 1, At, B1); PG8_BAR; PG8_SCHED;
            PG8_LDA(At, 1, 1); PG8_STAGE(PG8_SB(1, 0), b3, voffB); PG8_STAGE(PG8_SB(1, 1), b3 + hstep, voffB); PG8_STAGE(PG8_SA(1, 0), a3, voffA);
            PG8_WAIT_V(8); PG8_WAIT_L(0); PG8_BAR; PG8_MMA(1, 0, At, B0); PG8_MMA(1, 1, At, B1); PG8_BAR; PG8_SCHED;
            } else {
            PG8_LDB(B0, 0, 0); PG8_SCHED; PG8_LDA(At, 0, 0); PG8_STAGE(PG8_SA(1, 1), a1 + hstep, voffA);
            PG8_WAIT_L(8); PG8_BAR; PG8_WAIT_L(0); PG8_MMA(0, 0, At, B0); PG8_BAR; PG8_SCHED;
            PG8_LDB(B1, 0, 1); PG8_STAGE(PG8_SB(0, 0), b2, voffB);
            PG8_BAR; PG8_WAIT_L(0); PG8_MMA(0, 1, At, B1); PG8_BAR;
            PG8_LDA(At, 0, 1); PG8_STAGE(PG8_SA(0, 0), a2, voffA);
            PG8_BAR; PG8_WAIT_L(0); PG8_MMA(1, 0, At, B0); PG8_BAR; PG8_SCHED;
            PG8_STAGE(PG8_SB(0, 1), b2 + hstep, voffB);
            PG8_WAIT_V(6); PG8_BAR; PG8_MMA(1, 1, At, B1); PG8_BAR;
            PG8_LDB(B0, 1, 0); PG8_SCHED; PG8_LDA(At, 1, 0); PG8_STAGE(PG8_SA(0, 1), a2 + hstep, voffA);
            PG8_WAIT_L(8); PG8_BAR; PG8_WAIT_L(0); PG8_MMA(0, 0, At, B0); PG8_BAR; PG8_SCHED;
            PG8_LDB(B1, 1, 1); PG8_STAGE(PG8_SB(1, 0), b3, voffB);
            PG8_BAR; PG8_WAIT_L(0); PG8_MMA(0, 1, At, B1); PG8_BAR;
            PG8_LDA(At, 1, 1); PG8_STAGE(PG8_SA(1, 0), a3, voffA);
            PG8_BAR; PG8_WAIT_L(0); PG8_MMA(1, 0, At, B0); PG8_BAR; PG8_SCHED;
            PG8_STAGE(PG8_SB(1, 1), b3 + hstep, voffB);
            PG8_WAIT_V(6); PG8_BAR; PG8_MMA(1, 1, At, B1); PG8_BAR;
            }
        }
        if constexpr (ALIGN_EPI) { if (wr == 0) PG8_BAR; }
        if constexpr (!Epi::AFTER_DRAIN) { E(acc, cur, wr, wc, fr, fq); S.done(cur); }
        if (!has_next) break;
#pragma unroll
        for (int a = 0; a < 2; ++a)
#pragma unroll
            for (int b = 0; b < 2; ++b)
#pragma unroll
                for (int m = 0; m < 4; ++m)
#pragma unroll
                    for (int n = 0; n < 2; ++n) acc[a][b][m][n] = (f32x4){0.f, 0.f, 0.f, 0.f};
        cur = nxt; cA = nA; cB = nB; ++ui;
        if constexpr (ALIGN_EPI) { if (wr == 1) PG8_BAR; }
    }
    PG8_WAIT_V(0);
    if constexpr (!ALIGN_EPI) { if (wr == 0) PG8_BAR; }
    PG8_BAR;
    if constexpr (Epi::AFTER_DRAIN) { E.fused(acc, cur, wr, wc, fr, fq, lds, wid, lane); S.done(cur); }
#undef PG8_SA
#undef PG8_SB
#undef PG8_STAGE
#undef PG8_LDA
#undef PG8_LDB
#undef PG8_MMA
#undef PG8_WAIT_V
#undef PG8_WAIT_L
#undef PG8_BAR
#undef PG8_SCHED
}
}

#define LAS __attribute__((address_space(3)))
using pg8::bf16_t; using pg8::bf16x8; using pg8::f32x4; using pg8::u32x4; using pg8::Unit;
typedef float f32x2_t __attribute__((ext_vector_type(2))); typedef __bf16 bf16x2_t __attribute__((ext_vector_type(2)));
__device__ __forceinline__ unsigned cvt_pk_bf16(float lo, float hi) { f32x2_t v = {lo, hi}; bf16x2_t b = __builtin_convertvector(v, bf16x2_t); return __builtin_bit_cast(unsigned, b); }
typedef unsigned u32x2 __attribute__((ext_vector_type(2)));
typedef short s16x4 __attribute__((ext_vector_type(4)));
constexpr int DM = 1024, MP = 16384, MS = 256, M = MP + MS, DFF = 2816, NIN = 6656, BW = 512, PLE = 256;
constexpr int SEQ = 8192, DSEQ = 32, PAST = 2048, NB_P = 2, NB_S = 8;
constexpr float EPS = 1e-6f;
constexpr int NWAVES = 8, NTHR = 512;
constexpr int LDS_BYTES = 147456;

constexpr size_t MiB = 1u << 20;
constexpr size_t U1 = (size_t)M * 1024 * 2;
constexpr size_t WS_SS = 0, WS_LB = 1 * MiB, WS_EG = 2 * MiB, WS_W = 4 * MiB;
constexpr size_t W_GU1 = WS_W, W_D1 = W_GU1 + (size_t)5632 * 1024 * 2, W_IN = W_D1 + (size_t)1024 * 2816 * 2, W_A = W_IN + (size_t)6656 * 1024 * 2,
                 W_POOL = W_A + (size_t)1024 * 1024 * 2, W_B = W_POOL + (size_t)512 * 512 * 2, W_OUT = W_B + (size_t)1024 * 512 * 2, W_GU2 = W_OUT + (size_t)1024 * 1024 * 2,
                 W_D2 = W_GU2 + (size_t)5632 * 1024 * 2, W_PP = W_D2 + (size_t)1024 * 2816 * 2, W_PG = W_PP + (size_t)1024 * 256 * 2, W_END = W_PG + (size_t)1024 * 1024 * 2;
constexpr size_t WS_H = 59 * MiB, WS_Y = WS_H + U1, WS_BIG = WS_Y + U1;
constexpr size_t B_QP = WS_BIG, B_KP = WS_BIG + 33 * MiB, B_VB = WS_BIG + 66 * MiB, B_O = B_VB  , B_OG = WS_BIG + 99 * MiB, B_GA = B_QP + MiB / 2, B_GB = B_KP + MiB / 2;
constexpr size_t B_ACT = WS_BIG, B_E = WS_BIG, B_PB = W_GU1  ;
constexpr size_t WS_U = WS_Y, WS_POOLED = WS_Y + (size_t)M * 512 * 2, WS_PM = W_GU1  ;
constexpr size_t WS_NEED = B_OG + U1;
static_assert(W_END <= WS_H && WS_NEED <= 256 * MiB && (size_t)M * DFF * 2 <= 131 * MiB && U1 <= 33 * MiB - MiB / 2, "d_ws map");
constexpr size_t O_Y = 0, O_HP = (size_t)M * DM, O_PP = O_HP + (size_t)NB_P * 8 * 128 * 128, O_HS = O_PP + (size_t)NB_P * 15 * 512, O_PS = O_HS + (size_t)NB_S * 8 * 128 * 128;

__device__ __forceinline__ float bf2f(unsigned short v) { return __uint_as_float((unsigned)v << 16); }
__device__ __forceinline__ float bflo(unsigned w) { return __uint_as_float(w << 16); }
__device__ __forceinline__ float bfhi(unsigned w) { return __uint_as_float(w & 0xffff0000u); }
__device__ __forceinline__ f32x4 zero_acc() { f32x4 z = (f32x4){0.f, 0.f, 0.f, 0.f}; asm volatile("" : "+v"(z)); return z; }
__device__ __forceinline__ int otid() { int t = threadIdx.x; asm volatile("" : "+v"(t)); return t; }
__device__ __forceinline__ float fexp(float x) { return __builtin_amdgcn_exp2f(x * 1.44269504f); }
__device__ __forceinline__ float flog(float x) { return __builtin_amdgcn_logf(x) * 0.69314718f; }
__device__ __forceinline__ float frcp(float x) { return __builtin_amdgcn_rcpf(x); }
__device__ __forceinline__ float sigm(float x) { return frcp(1.0f + fexp(-x)); }
__device__ __forceinline__ float wave_sum(float v) {
#pragma unroll
    for (int o = 1; o < 64; o <<= 1) v += __shfl_xor(v, o);
    return v;
}
template <int CTRL> __device__ __forceinline__ float dppm(float x) { return __int_as_float(__builtin_amdgcn_update_dpp(0x3f800000, __float_as_int(x), CTRL, 0xf, 0xf, false)); }
template <int CTRL> __device__ __forceinline__ float dppf(float x) { return __int_as_float(__builtin_amdgcn_update_dpp(0, __float_as_int(x), CTRL, 0xf, 0xf, true)); }

struct TileSched {
    int nNp, pn0p, nNs, pn0s, nwgP, G, c;
    __device__ __forceinline__ void init(int nNp_, int pn0p_, int nNs_, int pn0s_, int G_, int c_) { nNp = nNp_; pn0p = pn0p_; nNs = nNs_; pn0s = pn0s_; nwgP = 64 * nNp_; G = G_; c = c_; }
    __device__ __forceinline__ bool next(int i, Unit& u) const {
        long L = (long)i * G + c;
        if (L < nwgP) {
            int wgid = (int)L; { const int q = nwgP / 8, xcd = wgid % 8, off = wgid / 8; wgid = xcd * q + off; }
            const int nig = 8 * nNp, gid = wgid / nig, fm = gid * 8;
            u.pm = fm + ((wgid % nig) % 8); u.pn = pn0p + (wgid % nig) / 8; return true;
        }
        L -= nwgP;
        if (L < nNs) { u.pm = 64; u.pn = pn0s + (int)L; return true; }
        return false;
    }
    __device__ __forceinline__ void a_ready(const Unit&) const {}
    __device__ __forceinline__ void done(const Unit&) const {}
};

#define EPI_ROWS(ai, m) (u.pm * 256 + (ai) * 128 + wr * 64 + (m) * 16 + fr)
__device__ __forceinline__ u32x4 pack8(const f32x4& a, const f32x4& b) { u32x4 w; w.x = cvt_pk_bf16(a[0], a[1]); w.y = cvt_pk_bf16(a[2], a[3]); w.z = cvt_pk_bf16(b[0], b[1]); w.w = cvt_pk_bf16(b[2], b[3]); return w; }
__device__ __forceinline__ void unpack8(const u32x4& w, f32x4& a, f32x4& b) { a = (f32x4){bflo(w.x), bfhi(w.x), bflo(w.y), bfhi(w.y)}; b = (f32x4){bflo(w.z), bfhi(w.z), bflo(w.w), bfhi(w.w)}; }

struct EpiSwiGLU {
    static constexpr bool PERM = true, AFTER_DRAIN = false;
    bf16_t* O;
    __device__ __forceinline__ void operator()(f32x4 (&acc)[2][2][4][2], const Unit& u, int wr, int wc, int fr, int fq) const {
        const int col0 = u.pn * 128 + wc * 32 + 8 * fq;
#pragma unroll
        for (int ai = 0; ai < 2; ++ai)
#pragma unroll
            for (int m = 0; m < 4; ++m) {
                f32x4 o[2];
#pragma unroll
                for (int n = 0; n < 2; ++n)
#pragma unroll
                    for (int j = 0; j < 4; ++j) { const float a = acc[ai][0][m][n][j], b = acc[ai][1][m][n][j]; o[n][j] = a * sigm(a) * b; }
                *(u32x4*)(O + (size_t)EPI_ROWS(ai, m) * DFF + col0) = pack8(o[0], o[1]);
            }
    }
};
template <bool SCALE> struct EpiStore {
    static constexpr bool PERM = true, AFTER_DRAIN = false;
    bf16_t* O; int ldc; const float* scale;
    __device__ __forceinline__ void operator()(f32x4 (&acc)[2][2][4][2], const Unit& u, int wr, int wc, int fr, int fq) const {
#pragma unroll
        for (int bj = 0; bj < 2; ++bj) {
            const int col0 = u.pn * 256 + bj * 128 + wc * 32 + 8 * fq;
            f32x4 s0 = (f32x4){1.f, 1.f, 1.f, 1.f}, s1 = s0;
            if (SCALE) { s0 = *(const f32x4*)(scale + col0); s1 = *(const f32x4*)(scale + col0 + 4); }
#pragma unroll
            for (int ai = 0; ai < 2; ++ai)
#pragma unroll
                for (int m = 0; m < 4; ++m) *(u32x4*)(O + (size_t)EPI_ROWS(ai, m) * ldc + col0) = pack8(acc[ai][bj][m][0] * s0, acc[ai][bj][m][1] * s1);
        }
    }
};
struct EpiMulInPlace {
    static constexpr bool PERM = true, AFTER_DRAIN = false;
    bf16_t* Gt;
    __device__ __forceinline__ void operator()(f32x4 (&acc)[2][2][4][2], const Unit& u, int wr, int wc, int fr, int fq) const {
#pragma unroll
        for (int bj = 0; bj < 2; ++bj) {
            const int col0 = u.pn * 256 + bj * 128 + wc * 32 + 8 * fq;
#pragma unroll
            for (int ai = 0; ai < 2; ++ai)
#pragma unroll
                for (int m = 0; m < 4; ++m) { bf16_t* p = Gt + (size_t)EPI_ROWS(ai, m) * DM + col0; f32x4 g0, g1; unpack8(*(const u32x4*)p, g0, g1);
                    *(u32x4*)p = pack8(g0 * acc[ai][bj][m][0], g1 * acc[ai][bj][m][1]); }
        }
    }
};
struct EpiFmaInPlace {
    static constexpr bool PERM = true, AFTER_DRAIN = false;
    const bf16_t* T1; bf16_t* Gb;
    __device__ __forceinline__ void operator()(f32x4 (&acc)[2][2][4][2], const Unit& u, int wr, int wc, int fr, int fq) const {
#pragma unroll
        for (int bj = 0; bj < 2; ++bj) {
            const int col0 = u.pn * 256 + bj * 128 + wc * 32 + 8 * fq;
#pragma unroll
            for (int ai = 0; ai < 2; ++ai)
#pragma unroll
                for (int m = 0; m < 4; ++m) { const size_t off = (size_t)EPI_ROWS(ai, m) * DM + col0; f32x4 g0, g1, t0, t1; unpack8(*(const u32x4*)(Gb + off), g0, g1); unpack8(*(const u32x4*)(T1 + off), t0, t1);
                    *(u32x4*)(Gb + off) = pack8(t0 + g0 * acc[ai][bj][m][0], t1 + g1 * acc[ai][bj][m][1]); }
        }
    }
};
struct EpiPleGate {
    static constexpr bool PERM = true, AFTER_DRAIN = false;
    const bf16_t* E; bf16_t* O;
    __device__ __forceinline__ void operator()(f32x4 (&acc)[2][2][4][2], const Unit& u, int wr, int wc, int fr, int fq) const {
#pragma unroll
        for (int bj = 0; bj < 2; ++bj) {
            const int col0 = u.pn * 256 + bj * 128 + wc * 32 + 8 * fq;
#pragma unroll
            for (int ai = 0; ai < 2; ++ai)
#pragma unroll
                for (int m = 0; m < 4; ++m) { const size_t off = (size_t)EPI_ROWS(ai, m) * DM + col0; f32x4 e0, e1; unpack8(*(const u32x4*)(E + off), e0, e1); f32x4 o0, o1;
#pragma unroll
                    for (int j = 0; j < 4; ++j) { o0[j] = sigm(acc[ai][bj][m][0][j]) * e0[j]; o1[j] = sigm(acc[ai][bj][m][1][j]) * e1[j]; }
                    *(u32x4*)(O + off) = pack8(o0, o1); }
        }
    }
};
struct EpiIn {
    static constexpr bool PERM = true, AFTER_DRAIN = false;
    unsigned char* ws; float* EG; const float* lb;
    __device__ __forceinline__ void operator()(f32x4 (&acc)[2][2][4][2], const Unit& u, int wr, int wc, int fr, int fq) const {
        const int cin = wc * 32 + 8 * fq;
        bf16_t* Qp = (bf16_t*)(ws + B_QP); bf16_t* Kp = (bf16_t*)(ws + B_KP);
        if (u.pn < 8) {
            const int h = u.pn; const bool smp = (u.pm == 64);
            const f32x4 lb0 = *(const f32x4*)(lb + h * 128 + cin), lb1 = *(const f32x4*)(lb + h * 128 + cin + 4);
#pragma unroll
            for (int ai = 0; ai < 2; ++ai) {
                f32x4 egA[2], egB[2];
#pragma unroll
                for (int n = 0; n < 2; ++n)
#pragma unroll
                    for (int j = 0; j < 4; ++j) {
                        const float lbv = n ? lb1[j] : lb0[j], omlb = 1.0f - lbv;
                        float inc[4], tot[4], kk[4];
#pragma unroll
                        for (int m = 0; m < 4; ++m) {
                            float fz = acc[ai][1][m][n][j]; fz = fminf(fmaxf(fz, -30.f), 30.f);
                            const float e = fexp(-fz), sg = frcp(1.0f + e);
                            kk[m] = omlb * e * sg;
                            float x = lbv + omlb * sg;
                            x *= dppm<0x111>(x); x *= dppm<0x112>(x); x *= dppm<0x114>(x); x *= dppm<0x118>(x);
                            inc[m] = x; tot[m] = dppf<0x15F>(x);
                        }
                        const float off1 = tot[0], off2 = smp ? 1.f : tot[0] * tot[1], off3 = off2 * tot[2];
                        const float lastA = smp ? tot[0] * tot[1] : off3 * tot[3], lastB = tot[2] * tot[3];
                        const float g[4] = {inc[0], inc[1] * off1, inc[2] * off2, inc[3] * off3};
#pragma unroll
                        for (int m = 0; m < 4; ++m) {
                            const float q = acc[ai][0][m][n][j];
                            const float eg_ = g[m], d_ = 1.0f + fexp(-fmaxf(q, -30.f)), r_ = frcp(d_ * eg_);
                            acc[ai][0][m][n][j] = (q * eg_) * (eg_ * r_);
                            acc[ai][1][m][n][j] = kk[m] * (d_ * r_);
                        }
                        egA[n][j] = lastA; egB[n][j] = lastB;
                    }
#pragma unroll
                for (int m = 0; m < 4; ++m) { const size_t off = (size_t)EPI_ROWS(ai, m) * DM + h * 128 + cin;
                    *(u32x4*)(Qp + off) = pack8(acc[ai][0][m][0], acc[ai][0][m][1]); *(u32x4*)(Kp + off) = pack8(acc[ai][1][m][0], acc[ai][1][m][1]); }
                if (fr == 0) {
                    if (!smp) { float* p = EG + (size_t)(u.pm * 4 + ai * 2 + wr) * 1024 + h * 128 + cin; *(f32x4*)p = egA[0]; *(f32x4*)(p + 4) = egA[1]; }
                    else { float* p = EG + (size_t)(256 + ai * 4 + wr * 2) * 1024 + h * 128 + cin; *(f32x4*)p = egA[0]; *(f32x4*)(p + 4) = egA[1]; *(f32x4*)(p + 1024) = egB[0]; *(f32x4*)(p + 1028) = egB[1]; }
                }
            }
            return;
        }
        size_t boff; int ldc, c0, act;
        if (u.pn < 12) { boff = B_VB; ldc = 1024; c0 = (u.pn - 8) * 256; act = 0; }
        else if (u.pn < 14) { boff = WS_U; ldc = 512; c0 = (u.pn - 12) * 256; act = 0; }
        else if (u.pn < 18) { boff = B_OG; ldc = 1024; c0 = (u.pn - 14) * 256; act = 1; }
        else if (u.pn < 22) { boff = B_GA; ldc = 1024; c0 = (u.pn - 18) * 256; act = 2; }
        else { boff = B_GB; ldc = 1024; c0 = (u.pn - 22) * 256; act = 2; }
        bf16_t* O = (bf16_t*)(ws + boff);
#pragma unroll
        for (int bj = 0; bj < 2; ++bj)
#pragma unroll
            for (int ai = 0; ai < 2; ++ai)
#pragma unroll
                for (int m = 0; m < 4; ++m) {
                    f32x4 o[2];
#pragma unroll
                    for (int n = 0; n < 2; ++n)
#pragma unroll
                        for (int j = 0; j < 4; ++j) { const float x = acc[ai][bj][m][n][j]; const float s = sigm(x); o[n][j] = act == 0 ? x : (act == 1 ? x * s : s); }
                    *(u32x4*)(O + (size_t)EPI_ROWS(ai, m) * ldc + c0 + bj * 128 + cin) = pack8(o[0], o[1]);
                }
    }
};

__device__ __forceinline__ u32x2 pack4(const f32x4& a) { u32x2 w; w.x = cvt_pk_bf16(a[0], a[1]); w.y = cvt_pk_bf16(a[2], a[3]); return w; }
__device__ __forceinline__ f32x4 unpack4(const u32x2& w) { return (f32x4){bflo(w.x), bfhi(w.x), bflo(w.y), bfhi(w.y)}; }
struct SStore { bf16_t* O; int ldc; const float* scale;
    __device__ __forceinline__ void operator()(int row, int col, f32x4 v) const { if (scale) v = v * *(const f32x4*)(scale + col); *(u32x2*)(O + (size_t)row * ldc + col) = pack4(v); } };
struct SMulInPlace { bf16_t* Gt;
    __device__ __forceinline__ void operator()(int row, int col, f32x4 v) const { bf16_t* p = Gt + (size_t)row * DM + col; *(u32x2*)p = pack4(unpack4(*(const u32x2*)p) * v); } };
struct SFmaInPlace { const bf16_t* T1; bf16_t* Gb;
    __device__ __forceinline__ void operator()(int row, int col, f32x4 v) const { const size_t off = (size_t)row * DM + col; *(u32x2*)(Gb + off) = pack4(unpack4(*(const u32x2*)(T1 + off)) + unpack4(*(const u32x2*)(Gb + off)) * v); } };
struct SPleGate { const bf16_t* E; bf16_t* O;
    __device__ __forceinline__ void operator()(int row, int col, f32x4 v) const { const size_t off = (size_t)row * DM + col; const f32x4 e = unpack4(*(const u32x2*)(E + off)); f32x4 o;
#pragma unroll
        for (int j = 0; j < 4; ++j) o[j] = sigm(v[j]) * e[j];
        *(u32x2*)(O + off) = pack4(o); } };
template <class Epi> __device__ __forceinline__ void sgemm_sample(LAS unsigned char* lds, const bf16_t* A, const bf16_t* Bt, int N, int K, const Epi& E, int bx, int G, int wave, int lane) {
    const int fr = lane & 15, fq = lane >> 4, nblk = N >> 2, per = K >> 8;
    LAS f32x4* slots = (LAS f32x4*)lds;
    for (int bt = bx; bt < nblk; bt += G) {
        const int rb = bt & 7, cb = bt >> 3;
        const bf16_t* ap = A + (size_t)(MP + 32 * rb + fr) * K + 32 * (wave * per) + 8 * fq;
        const bf16_t* bp = Bt + (size_t)(32 * cb + fr) * K + 32 * (wave * per) + 8 * fq;
        const size_t r16 = (size_t)16 * K;
        f32x4 acc00 = zero_acc(), acc01 = zero_acc(), acc10 = zero_acc(), acc11 = zero_acc();
        for (int s0 = 0; s0 < per; s0 += 4) {
            bf16x8 a0[4], a1[4], b0[4], b1[4];
#pragma unroll
            for (int u = 0; u < 4; ++u) { const int su = (s0 + u < per) ? s0 + u : per - 1;
                a0[u] = *(const bf16x8*)(ap + 32 * su); a1[u] = *(const bf16x8*)(ap + r16 + 32 * su); b0[u] = *(const bf16x8*)(bp + 32 * su); b1[u] = *(const bf16x8*)(bp + r16 + 32 * su); }
#pragma unroll
            for (int u = 0; u < 4; ++u) { if (s0 + u < per) {
                acc00 = __builtin_amdgcn_mfma_f32_16x16x32_bf16(b0[u], a0[u], acc00, 0, 0, 0); acc01 = __builtin_amdgcn_mfma_f32_16x16x32_bf16(b1[u], a0[u], acc01, 0, 0, 0);
                acc10 = __builtin_amdgcn_mfma_f32_16x16x32_bf16(b0[u], a1[u], acc10, 0, 0, 0); acc11 = __builtin_amdgcn_mfma_f32_16x16x32_bf16(b1[u], a1[u], acc11, 0, 0, 0); } }
        }
        __syncthreads();
        slots[(wave * 4 + 0) * 64 + lane] = acc00; slots[(wave * 4 + 1) * 64 + lane] = acc01; slots[(wave * 4 + 2) * 64 + lane] = acc10; slots[(wave * 4 + 3) * 64 + lane] = acc11;
        __syncthreads();
        if (wave < 4) {
            f32x4 sum = slots[(0 * 4 + wave) * 64 + lane];
#pragma unroll
            for (int w = 1; w < 8; ++w) sum = sum + slots[(w * 4 + wave) * 64 + lane];
            const int i = wave >> 1, j = wave & 1;
            E(MP + 32 * rb + 16 * i + fr, 32 * cb + 16 * j + 4 * fq, sum);
        }
    }
    __syncthreads();
}

__device__ __forceinline__ unsigned pk2(float lo, float hi) { return cvt_pk_bf16(lo, hi); }
__device__ __forceinline__ void transpose_item(const float* W, int ldn, int src_n0, int K, bf16_t* WT, int dst_n0, int k0, LAS float* scr, int lane) {
    const int nq = (lane & 7) * 4, kr = lane >> 3;
    f32x4 v[8];
#pragma unroll
    for (int i = 0; i < 8; ++i) v[i] = *(const f32x4*)(W + (size_t)(k0 + 8 * i + kr) * ldn + src_n0 + nq);
#pragma unroll
    for (int i = 0; i < 8; ++i) { LAS float* d = scr + (8 * i + kr) * 33 + nq; d[0] = v[i].x; d[1] = v[i].y; d[2] = v[i].z; d[3] = v[i].w; }
    asm volatile("s_waitcnt lgkmcnt(0)" ::: "memory");
    const int c = lane & 7;
#pragma unroll
    for (int j = 0; j < 4; ++j) { const int n = (lane >> 3) + 8 * j; const LAS float* s = scr + (8 * c) * 33 + n;
        u32x4 o; o.x = pk2(s[0 * 33], s[1 * 33]); o.y = pk2(s[2 * 33], s[3 * 33]); o.z = pk2(s[4 * 33], s[5 * 33]); o.w = pk2(s[6 * 33], s[7 * 33]);
        *(u32x4*)(WT + (size_t)(dst_n0 + n) * K + k0 + 8 * c) = o; }
    asm volatile("s_waitcnt lgkmcnt(0)" ::: "memory");
}
__device__ __forceinline__ int map_gu(int n) { const int pn = n >> 8, bj = (n >> 7) & 1, jj = n & 127; return bj * DFF + pn * 128 + jj; }
__device__ __forceinline__ int map_in(int n) {
    if (n < 2048) { const int h = n >> 8, bj = (n >> 7) & 1, kk = n & 127; return bj * 1024 + h * 128 + kk; }
    if (n < 3072) return n;
    if (n < 3584) return 4096 + (n - 3072);
    if (n < 4608) return 3072 + (n - 3584);
    return n;
}
__device__ __forceinline__ void rms_row_to_bf16(const float* xrow, const float* g, bf16_t* orow, int lane) {
    const f32x4* xr = (const f32x4*)xrow + lane; f32x4 v[4]; float s = 0.f;
#pragma unroll
    for (int j = 0; j < 4; ++j) { v[j] = xr[64 * j]; s += (v[j].x * v[j].x + v[j].y * v[j].y) + (v[j].z * v[j].z + v[j].w * v[j].w); }
    const float r = rsqrtf(wave_sum(s) * (1.f / 1024.f) + EPS);
    u32x2* o8 = (u32x2*)orow + lane;
#pragma unroll
    for (int j = 0; j < 4; ++j) { const f32x4 gg = ((const f32x4*)g)[lane + 64 * j]; u32x2 w; w.x = pk2(v[j].x * r * gg.x, v[j].y * r * gg.y); w.y = pk2(v[j].z * r * gg.z, v[j].w * r * gg.w); o8[64 * j] = w; }
}
template <bool HAS_H> __device__ __forceinline__ void row_phase(const bf16_t* Y, const float* xin_p, const float* xin_s, float* xout, bf16_t* H, const float* g_post, float coef, const float* g_pre, int gw, int NGW, int lane) {
    for (int m = gw; m < M; m += NGW) {
        const float* xi = (m < MP) ? xin_p + (size_t)m * DM : xin_s + (size_t)(m - MP) * DM;
        const u32x2* yr = (const u32x2*)(Y + (size_t)m * DM) + lane; f32x4 y[4], x[4]; float s = 0.f;
#pragma unroll
        for (int j = 0; j < 4; ++j) { const u32x2 w = __builtin_nontemporal_load(yr + 64 * j); y[j] = (f32x4){bflo(w.x), bfhi(w.x), bflo(w.y), bfhi(w.y)}; x[j] = __builtin_nontemporal_load((const f32x4*)xi + lane + 64 * j);
            s += (y[j].x * y[j].x + y[j].y * y[j].y) + (y[j].z * y[j].z + y[j].w * y[j].w); }
        const float r = rsqrtf(wave_sum(s) * (1.f / 1024.f) + EPS) * coef; float s2 = 0.f;
#pragma unroll
        for (int j = 0; j < 4; ++j) { const f32x4 gg = ((const f32x4*)g_post)[lane + 64 * j]; x[j] = x[j] + y[j] * gg * r; __builtin_nontemporal_store(x[j], (f32x4*)(xout + (size_t)m * DM) + lane + 64 * j);
            s2 += (x[j].x * x[j].x + x[j].y * x[j].y) + (x[j].z * x[j].z + x[j].w * x[j].w); }
        if (HAS_H) {
            const float r2 = rsqrtf(wave_sum(s2) * (1.f / 1024.f) + EPS); u32x2* o8 = (u32x2*)(H + (size_t)m * DM) + lane;
#pragma unroll
            for (int j = 0; j < 4; ++j) { const f32x4 gg = ((const f32x4*)g_pre)[lane + 64 * j]; u32x2 w; w.x = pk2(x[j].x * r2 * gg.x, x[j].y * r2 * gg.y); w.y = pk2(x[j].z * r2 * gg.z, x[j].w * r2 * gg.w); o8[64 * j] = w; }
        }
    }
}

constexpr int HP = 136, L_QKBUF = 2 * 64 * HP * 2, L_KOFF = 64 * HP * 2, L_VT = 2 * L_QKBUF, L_VTSZ = 16 * 72 * 2, L_AL = L_VT + 2 * L_VTSZ, L_ALSZ = 64 * 72 * 2, L_ST = L_AL + 2 * L_ALSZ, L_STSZ = 16 * HP * 2;
static_assert(L_ST + 2 * L_STSZ <= 131072, "hgrn lds");
#define HG_LOAD2(c, RQ, RK, RV, EGN) do { _Pragma("unroll") for (int j_ = 0; j_ < 2; ++j_) { const int row_ = prow0 + 32 * j_, rowc_ = row_ < T ? row_ : T - 1; const size_t go_ = (size_t)(row0 + (c) * 64 + rowc_) * DM + qcol + pch * 8; \
            RQ[j_] = *(const u32x4*)(Qp + go_); RK[j_] = *(const u32x4*)(Kp + go_); } \
            { const int vrc_ = vrow < T ? vrow : T - 1; RV = *(const u32x4*)(Vb + (size_t)(row0 + (c) * 64 + vrc_) * DM + vcol + vhalf * 8); } \
            EGN = *(const f32x4*)(EG + (size_t)(cid0 + (c)) * 1024 + h * 128 + 16 * wave + 4 * fq); } while (0)
#define HG_WRITE2(bf, RQ, RK, RV) do { LAS unsigned char* qb_ = lds + (bf) * L_QKBUF; _Pragma("unroll") for (int j_ = 0; j_ < 2; ++j_) { const int row_ = prow0 + 32 * j_; const bool z_ = row_ >= T; \
            u32x4 q_ = RQ[j_], k_ = RK[j_]; if (z_) { q_ = (u32x4){0u, 0u, 0u, 0u}; k_ = q_; } \
            *(LAS u32x4*)(qb_ + (row_ * HP + pch * 8) * 2) = q_; *(LAS u32x4*)(qb_ + L_KOFF + (row_ * HP + pch * 8) * 2) = k_; } \
            if (tid < 128) { u32x4 v_ = RV; if (vrow >= T) v_ = (u32x4){0u, 0u, 0u, 0u}; LAS unsigned short* vt_ = (LAS unsigned short*)(lds + L_VT + (bf) * L_VTSZ) + (vhalf * 8) * 72 + vrow; \
                vt_[0 * 72] = (unsigned short)v_.x; vt_[1 * 72] = (unsigned short)(v_.x >> 16); vt_[2 * 72] = (unsigned short)v_.y; vt_[3 * 72] = (unsigned short)(v_.y >> 16); \
                vt_[4 * 72] = (unsigned short)v_.z; vt_[5 * 72] = (unsigned short)(v_.z >> 16); vt_[6 * 72] = (unsigned short)v_.w; vt_[7 * 72] = (unsigned short)(v_.w >> 16); } } while (0)
#define HG_STEP(cc) do { const int c_ = (cc); const int bf = c_ & 1; \
            if (wave < 4) __builtin_amdgcn_s_setprio(2);   \
            if (wave < 4 && c_ > 0) { \
                const LAS unsigned char* ALp = lds + L_AL + (bf ^ 1) * L_ALSZ; \
                const int tt = wave, nks = (tt >> 1) + 1; \
                { const bf16x8 af = *(const LAS bf16x8*)(ALp + ((16 * tt + fr) * 72 + 8 * fq) * 2); oprev = __builtin_amdgcn_mfma_f32_16x16x32_bf16(vprev0, af, oprev, 0, 0, 0); } \
                if (nks > 1) { const bf16x8 af = *(const LAS bf16x8*)(ALp + ((16 * tt + fr) * 72 + 32 + 8 * fq) * 2); oprev = __builtin_amdgcn_mfma_f32_16x16x32_bf16(vprev1, af, oprev, 0, 0, 0); } \
                const int t = 16 * tt + fr; \
                if (t < T) { const size_t grow = (size_t)(row0 + (c_ - 1) * 64 + t); u32x2 w; w.x = pk2(oprev[0], oprev[1]); w.y = pk2(oprev[2], oprev[3]); *(u32x2*)(Ob + grow * DM + vcol + 4 * fq) = w; } \
            } \
            if (c_ < nch) { \
            const LAS unsigned char* QL = lds + bf * L_QKBUF; const LAS unsigned char* KL = QL + L_KOFF; const LAS unsigned char* VT = lds + L_VT + bf * L_VTSZ; \
            const LAS unsigned char* STo = lds + L_ST + bf * L_STSZ; LAS unsigned char* STn = lds + L_ST + (bf ^ 1) * L_STSZ; LAS unsigned char* AL = lds + L_AL + bf * L_ALSZ; \
            f32x4 oacc = zero_acc(); \
            if (wave < 4) { \
                const int tt = wave; bf16x8 qf[4]; \
_Pragma("unroll") \
                for (int ks = 0; ks < 4; ++ks) qf[ks] = *(const LAS bf16x8*)(QL + ((16 * tt + fr) * HP + 32 * ks + 8 * fq) * 2); \
                f32x4 a = zero_acc(); \
_Pragma("unroll") \
                for (int ks = 0; ks < 4; ++ks) { const bf16x8 kf = *(const LAS bf16x8*)(KL + ((16 * tt + fr) * HP + 32 * ks + 8 * fq) * 2); a = __builtin_amdgcn_mfma_f32_16x16x32_bf16(kf, qf[ks], a, 0, 0, 0); } \
_Pragma("unroll") \
                for (int i = 0; i < 4; ++i) if (4 * fq + i > fr) a[i] = 0.f; \
                { u32x2 w; w.x = pk2(a[0], a[1]); w.y = pk2(a[2], a[3]); *(LAS u32x2*)(AL + ((16 * tt + fr) * 72 + 16 * tt + 4 * fq) * 2) = w; } \
_Pragma("unroll") \
                for (int ks = 0; ks < 4; ++ks) { const bf16x8 sf = *(const LAS bf16x8*)(STo + (fr * HP + 32 * ks + 8 * fq) * 2); oacc = __builtin_amdgcn_mfma_f32_16x16x32_bf16(sf, qf[ks], oacc, 0, 0, 0); } \
            } else { \
                if (wave == 4) { bf16x8 kf[4];   \
_Pragma("unroll") \
                    for (int ks = 0; ks < 4; ++ks) kf[ks] = *(const LAS bf16x8*)(KL + (fr * HP + 32 * ks + 8 * fq) * 2); \
_Pragma("unroll") \
                    for (int tt = 1; tt < 3; ++tt) { f32x4 a = zero_acc(); \
_Pragma("unroll") \
                        for (int ks = 0; ks < 4; ++ks) { const bf16x8 qf = *(const LAS bf16x8*)(QL + ((16 * tt + fr) * HP + 32 * ks + 8 * fq) * 2); a = __builtin_amdgcn_mfma_f32_16x16x32_bf16(kf[ks], qf, a, 0, 0, 0); } \
                        u32x2 w; w.x = pk2(a[0], a[1]); w.y = pk2(a[2], a[3]); *(LAS u32x2*)(AL + ((16 * tt + fr) * 72 + 4 * fq) * 2) = w; } \
                } else if (wave == 5) { bf16x8 qf[4];   \
_Pragma("unroll") \
                    for (int ks = 0; ks < 4; ++ks) qf[ks] = *(const LAS bf16x8*)(QL + ((48 + fr) * HP + 32 * ks + 8 * fq) * 2); \
_Pragma("unroll") \
                    for (int st = 0; st < 2; ++st) { f32x4 a = zero_acc(); \
_Pragma("unroll") \
                        for (int ks = 0; ks < 4; ++ks) { const bf16x8 kf = *(const LAS bf16x8*)(KL + ((16 * st + fr) * HP + 32 * ks + 8 * fq) * 2); a = __builtin_amdgcn_mfma_f32_16x16x32_bf16(kf, qf[ks], a, 0, 0, 0); } \
                        u32x2 w; w.x = pk2(a[0], a[1]); w.y = pk2(a[2], a[3]); *(LAS u32x2*)(AL + ((48 + fr) * 72 + 16 * st + 4 * fq) * 2) = w; } \
                } else { const int tt = (wave == 6) ? 2 : 3, st = tt - 1;   \
                    f32x4 a = zero_acc(); \
_Pragma("unroll") \
                    for (int ks = 0; ks < 4; ++ks) { const bf16x8 kf = *(const LAS bf16x8*)(KL + ((16 * st + fr) * HP + 32 * ks + 8 * fq) * 2); const bf16x8 qf = *(const LAS bf16x8*)(QL + ((16 * tt + fr) * HP + 32 * ks + 8 * fq) * 2); \
                        a = __builtin_amdgcn_mfma_f32_16x16x32_bf16(kf, qf, a, 0, 0, 0); } \
                    u32x2 w; w.x = pk2(a[0], a[1]); w.y = pk2(a[2], a[3]); *(LAS u32x2*)(AL + ((16 * tt + fr) * 72 + 16 * st + 4 * fq) * 2) = w; \
                } \
            } \
            bf16x8 vf[2]; \
_Pragma("unroll") \
            for (int ks = 0; ks < 2; ++ks) vf[ks] = *(const LAS bf16x8*)(VT + (fr * 72 + 32 * ks + 8 * fq) * 2); \
            {   \
              const unsigned ka_ = (unsigned)(__UINTPTR_TYPE__)KL + (unsigned)((8 * fq + (fr >> 2)) * (HP * 2) + 32 * wave + 8 * (fr & 3)); \
              s16x4 k00, k01, k10, k11; \
              asm volatile("ds_read_b64_tr_b16 %0, %4\n\tds_read_b64_tr_b16 %1, %4 offset:%5\n\tds_read_b64_tr_b16 %2, %4 offset:%6\n\tds_read_b64_tr_b16 %3, %4 offset:%7\n\ts_waitcnt lgkmcnt(0)" \
                           : "=&v"(k00), "=&v"(k01), "=&v"(k10), "=&v"(k11) : "v"(ka_), "n"(4 * HP * 2), "n"(32 * HP * 2), "n"(36 * HP * 2) : "memory"); \
              const bf16x8 kt0 = __builtin_shufflevector(k00, k01, 0, 1, 2, 3, 4, 5, 6, 7), kt1 = __builtin_shufflevector(k10, k11, 0, 1, 2, 3, 4, 5, 6, 7); \
              S = __builtin_amdgcn_mfma_f32_16x16x32_bf16(kt0, vf[0], S, 0, 0, 0); S = __builtin_amdgcn_mfma_f32_16x16x32_bf16(kt1, vf[1], S, 0, 0, 0); } \
            { S = S * eg; \
              u32x2 w; w.x = pk2(S[0], S[1]); w.y = pk2(S[2], S[3]); *(LAS u32x2*)(STn + (fr * HP + 16 * wave + 4 * fq) * 2) = w; } \
            oprev = oacc; vprev0 = vf[0]; vprev1 = vf[1]; \
            } \
            __builtin_amdgcn_s_setprio(0); \
        } while (0)
__device__ __forceinline__ void hgrn_phase(LAS unsigned char* lds, const bf16_t* Qp, const bf16_t* Kp, const bf16_t* Vb, bf16_t* Ob, const float* EG, const float* state_in, float* out_hp, float* out_hs, int G, int bx, int tid) {
    const int wave = __builtin_amdgcn_readfirstlane(tid >> 6), lane = tid & 63, fr = lane & 15, fq = lane >> 4;
    for (int i = tid; i < 2 * 64 * 72 / 2; i += NTHR) ((LAS unsigned*)(lds + L_AL))[i] = 0u;
    for (int item = bx; item < 640; item += G) {
        int b, h, slice, row0, nch, T, cid0; const float* S0; float* Sout;
        if (item < 128) { const int seq = item & 15; slice = item >> 4; b = seq >> 3; h = seq & 7; row0 = b * SEQ; nch = SEQ / 64; T = 64; cid0 = b * (SEQ / 64); S0 = nullptr; Sout = out_hp + (size_t)(b * 8 + h) * 16384; }
        else { const int j = item - 128, seq = j & 63; slice = j >> 6; b = seq >> 3; h = seq & 7; row0 = MP + b * DSEQ; nch = 1; T = DSEQ; cid0 = 256 + b; S0 = state_in + (size_t)(b * 8 + h) * 16384; Sout = out_hs + (size_t)(b * 8 + h) * 16384; }
        const int qcol = h * 128, vcol = h * 128 + slice * 16;
        f32x4 S;
#pragma unroll
        for (int i = 0; i < 4; ++i) S[i] = S0 ? S0[(size_t)(16 * wave + 4 * fq + i) * 128 + slice * 16 + fr] : 0.f;
        __syncthreads();
        { u32x2 w; w.x = pk2(S[0], S[1]); w.y = pk2(S[2], S[3]); *(LAS u32x2*)(lds + L_ST + (fr * HP + 16 * wave + 4 * fq) * 2) = w; }
        u32x4 rq[2], rk[2], rv;
        const int prow0 = tid >> 4, pch = tid & 15;
#define HG_LOAD(c) do { _Pragma("unroll") for (int j_ = 0; j_ < 2; ++j_) { const int row_ = prow0 + 32 * j_, rowc_ = row_ < T ? row_ : T - 1; const size_t go_ = (size_t)(row0 + (c) * 64 + rowc_) * DM + qcol + pch * 8; \
            rq[j_] = *(const u32x4*)(Qp + go_); rk[j_] = *(const u32x4*)(Kp + go_); } \
            { const int vrc_ = vrow < T ? vrow : T - 1; rv = *(const u32x4*)(Vb + (size_t)(row0 + (c) * 64 + vrc_) * DM + vcol + vhalf * 8); } \
            egn = *(const f32x4*)(EG + (size_t)(cid0 + (c)) * 1024 + h * 128 + 16 * wave + 4 * fq); } while (0)
#define HG_WRITE(bf) do { LAS unsigned char* qb_ = lds + (bf) * L_QKBUF; _Pragma("unroll") for (int j_ = 0; j_ < 2; ++j_) { const int row_ = prow0 + 32 * j_; const bool z_ = row_ >= T; \
            u32x4 q_ = rq[j_], k_ = rk[j_]; if (z_) { q_ = (u32x4){0u, 0u, 0u, 0u}; k_ = q_; } \
            *(LAS u32x4*)(qb_ + (row_ * HP + pch * 8) * 2) = q_; *(LAS u32x4*)(qb_ + L_KOFF + (row_ * HP + pch * 8) * 2) = k_; } \
            if (tid < 128) { u32x4 v_ = rv; if (vrow >= T) v_ = (u32x4){0u, 0u, 0u, 0u}; LAS unsigned short* vt_ = (LAS unsigned short*)(lds + L_VT + (bf) * L_VTSZ) + (vhalf * 8) * 72 + vrow; \
                vt_[0 * 72] = (unsigned short)v_.x; vt_[1 * 72] = (unsigned short)(v_.x >> 16); vt_[2 * 72] = (unsigned short)v_.y; vt_[3 * 72] = (unsigned short)(v_.y >> 16); \
                vt_[4 * 72] = (unsigned short)v_.z; vt_[5 * 72] = (unsigned short)(v_.z >> 16); vt_[6 * 72] = (unsigned short)v_.w; vt_[7 * 72] = (unsigned short)(v_.w >> 16); } } while (0)
        f32x4 egn, eg;
        const int vrow = (tid & 127) >> 1, vhalf = tid & 1;
        u32x4 rqB[2], rkB[2], rvB; f32x4 egB;
#define CLAMPC(x) ((x) < nch ? (x) : nch - 1)
        HG_LOAD2(0, rq, rk, rv, egn); HG_WRITE2(0, rq, rk, rv); eg = egn;
        HG_LOAD2(CLAMPC(1), rq, rk, rv, egn);
        f32x4 oprev = zero_acc(); bf16x8 vprev0 = (bf16x8){0, 0, 0, 0, 0, 0, 0, 0}, vprev1 = vprev0;
        for (int c = 0; c <= nch; c += 2) {
            HG_LOAD2(CLAMPC(c + 2), rqB, rkB, rvB, egB);
            __syncthreads();
            HG_STEP(c);
            HG_WRITE2(1, rq, rk, rv); eg = egn;
            if (c + 1 > nch) break;
            HG_LOAD2(CLAMPC(c + 3), rq, rk, rv, egn);
            __syncthreads();
            HG_STEP(c + 1);
            HG_WRITE2(0, rqB, rkB, rvB); eg = egB;
        }
#undef CLAMPC
#pragma unroll
        for (int i = 0; i < 4; ++i) Sout[(size_t)(16 * wave + 4 * fq + i) * 128 + slice * 16 + fr] = S[i];
#undef HG_LOAD
#undef HG_WRITE
    }
}

__device__ __forceinline__ void prep_og(const bf16_t* Ob, bf16_t* OG, const float* gn, int gw, int NGW, int lane) {
    for (int m = gw; m < M; m += NGW) {
#pragma unroll
        for (int j = 0; j < 2; ++j) {
            const int col = lane * 8 + 512 * j;
            f32x4 o0, o1, g0, g1; unpack8(*(const u32x4*)(Ob + (size_t)m * DM + col), o0, o1); unpack8(*(const u32x4*)(OG + (size_t)m * DM + col), g0, g1);
            float ssq = (o0.x * o0.x + o0.y * o0.y) + (o0.z * o0.z + o0.w * o0.w) + (o1.x * o1.x + o1.y * o1.y) + (o1.z * o1.z + o1.w * o1.w);
            ssq += __shfl_xor(ssq, 1); ssq += __shfl_xor(ssq, 2); ssq += __shfl_xor(ssq, 4); ssq += __shfl_xor(ssq, 8);
            const float rs = rsqrtf(ssq * (1.f / 128.f) + EPS);
            const f32x4 n0 = *(const f32x4*)(gn + (col & 127)), n1 = *(const f32x4*)(gn + (col & 127) + 4);
            *(u32x4*)(OG + (size_t)m * DM + col) = pack8(o0 * n0 * g0 * rs, o1 * n1 * g1 * rs);
        }
    }
}
__device__ __forceinline__ void pool_row(const bf16_t* Ub, bf16_t* POOLED, const float* state_pool, float* out_pp, float* out_ps, int m, int lane) {
    int t, pos, TL; const float* buf; float* po;
    if (m < MP) { const int b = m / SEQ; t = m % SEQ; pos = t; TL = SEQ; buf = nullptr; po = out_pp + (size_t)b * 15 * 512; }
    else { const int b = (m - MP) / DSEQ; t = (m - MP) % DSEQ; pos = PAST + t; TL = DSEQ; buf = state_pool + (size_t)b * 15 * 512; po = out_ps + (size_t)b * 15 * 512; }
    const int col = lane * 8, w = 2 << (lane >> 4);
    f32x4 s0 = (f32x4){0.f, 0.f, 0.f, 0.f}, s1 = s0, u0 = s0, u1 = s0;
    for (int jj = 0; jj < w; ++jj) {
        const int tt = t - jj; f32x4 a0, a1;
        if (tt >= 0) unpack8(*(const u32x4*)(Ub + (size_t)(m - jj) * BW + col), a0, a1);
        else if (buf) { a0 = *(const f32x4*)(buf + (size_t)(15 + tt) * 512 + col); a1 = *(const f32x4*)(buf + (size_t)(15 + tt) * 512 + col + 4); }
        else { a0 = (f32x4){0.f, 0.f, 0.f, 0.f}; a1 = a0; }
        if (jj == 0) { u0 = a0; u1 = a1; }
        s0 = s0 + a0; s1 = s1 + a1;
    }
    const float ic = 1.0f / (float)((pos + 1 < w) ? pos + 1 : w);
    *(u32x4*)(POOLED + (size_t)m * BW + col) = pack8(s0 * ic - u0, s1 * ic - u1);
    if (t >= TL - 15) { float* p = po + (size_t)(t - (TL - 15)) * 512 + col; *(f32x4*)p = u0; *(f32x4*)(p + 4) = u1; }
}
__device__ __forceinline__ void prep_pool(const bf16_t* Ub, bf16_t* POOLED, const float* state_pool, float* out_pp, float* out_ps, int gw, int NGW, int lane) {
    const int col = lane * 8, w = 2 << (lane >> 4); const float ic = 1.0f / (float)w;
    for (int m0 = gw; m0 < M; m0 += 2 * NGW) {
        const int m1 = m0 + NGW; const bool two = m1 < M;
        const int t0 = (m0 < MP) ? m0 % SEQ : (m0 - MP) % DSEQ, t1 = two ? ((m1 < MP) ? m1 % SEQ : (m1 - MP) % DSEQ) : 0;
        if (two && t0 >= 15 && t1 >= 15) {
            u32x4 r0[16], r1[16];
#pragma unroll
            for (int jj = 0; jj < 16; ++jj) { r0[jj] = (u32x4){0u, 0u, 0u, 0u}; r1[jj] = r0[jj];
                if (jj < w) { r0[jj] = *(const u32x4*)(Ub + (size_t)(m0 - jj) * BW + col); r1[jj] = *(const u32x4*)(Ub + (size_t)(m1 - jj) * BW + col); } }
#pragma unroll
            for (int h = 0; h < 2; ++h) {
                const int m = h ? m1 : m0, t = h ? t1 : t0;
                f32x4 s0 = (f32x4){0.f, 0.f, 0.f, 0.f}, s1 = s0, u0 = s0, u1 = s0;
#pragma unroll
                for (int jj = 0; jj < 16; ++jj) { f32x4 a0, a1; unpack8(h ? r1[jj] : r0[jj], a0, a1); s0 = s0 + a0; s1 = s1 + a1; if (jj == 0) { u0 = a0; u1 = a1; } }
                *(u32x4*)(POOLED + (size_t)m * BW + col) = pack8(s0 * ic - u0, s1 * ic - u1);
                const int TL = (m < MP) ? SEQ : DSEQ;
                if (t >= TL - 15) { float* po = (m < MP) ? out_pp + (size_t)(m / SEQ) * 15 * 512 : out_ps + (size_t)((m - MP) / DSEQ) * 15 * 512;
                    float* p = po + (size_t)(t - (TL - 15)) * 512 + col; *(f32x4*)p = u0; *(f32x4*)(p + 4) = u1; }
            }
        } else { pool_row(Ub, POOLED, state_pool, out_pp, out_ps, m0, lane); if (two) pool_row(Ub, POOLED, state_pool, out_pp, out_ps, m1, lane); }
    }
}

typedef __attribute__((address_space(1))) unsigned gu32;
#define XB_TMO      128
#define XB_XCNT(j)  (256  + 64 * (j))
#define XB_XSUB(j)  (1280 + 64 * (j))
#define XB_XGEN(j)  (2304 + 64 * (j))
#define XB_TOP      3328
#define XB_TOPGEN   3392
#define XCD_BAR_WORDS 3456
#define XB_SPIN_CAP (1u << 18)

__device__ __forceinline__ unsigned xb_ld(unsigned* p)              { return __hip_atomic_load(p, __ATOMIC_RELAXED, __HIP_MEMORY_SCOPE_AGENT); }
__device__ __forceinline__ unsigned xb_add(unsigned* p, unsigned v) { return __hip_atomic_fetch_add(p, v, __ATOMIC_RELAXED, __HIP_MEMORY_SCOPE_AGENT); }
__device__ __forceinline__ unsigned xb_xcc_id() { return (unsigned)__builtin_amdgcn_s_getreg((3 << 11) | 20) & 0xFu; }
#define XB_SPIN(cond, bar) do { unsigned _sp = 0; while (cond) { __builtin_amdgcn_s_sleep(1); \
    if ((++_sp & 255u) == 0u) { if (xb_ld(&(bar)[XB_TMO])) break; if (_sp > XB_SPIN_CAP) { atomicAdd(&(bar)[XB_TMO], 1u); break; } } } } while (0)

struct XcdBarrier {
    unsigned* bar; unsigned x;
    volatile LAS unsigned* st;
};

__device__ __forceinline__ XcdBarrier xcd_barrier_post(unsigned* bar, volatile LAS unsigned* st) {
    XcdBarrier b; b.bar = bar; b.x = xb_xcc_id(); b.st = st;
    if (threadIdx.x == 0) (void)xb_add(&bar[XB_XCNT(b.x)], 1u);
    return b;
}
__device__ __forceinline__ void xcd_barrier_complete(unsigned* bar, unsigned x, unsigned& nloc, unsigned& nx) {
    const unsigned G = gridDim.x * gridDim.y * gridDim.z;
    unsigned sum, cnt, mine, sp = 0u;
    for (;;) {
        sum = 0u; cnt = 0u; mine = 0u;
#pragma unroll
        for (unsigned j = 0; j < 16; ++j) { const unsigned c = xb_ld(&bar[XB_XCNT(j)]); sum += c; cnt += (c > 0u) ? 1u : 0u; mine = (j == x) ? c : mine; }
        if (sum == G) break;
        __builtin_amdgcn_s_sleep(1);
        if ((++sp & 255u) == 0u) { if (xb_ld(&bar[XB_TMO])) break; if (sp > XB_SPIN_CAP) { atomicAdd(&bar[XB_TMO], 1u); break; } }
    }
    nloc = mine > 0u ? mine : 1u; nx = cnt > 0u ? cnt : 1u;
}

__device__ __forceinline__ void xcd_barrier(const XcdBarrier& b) {
    asm volatile("s_waitcnt vmcnt(0)" ::: "memory");
    __syncthreads();
    if (threadIdx.x == 0) {
        unsigned* bar = b.bar;
        __builtin_amdgcn_s_waitcnt(0);
        unsigned nloc = b.st[0], nx = b.st[1];
        if (nloc == 0u) { xcd_barrier_complete(bar, b.x, nloc, nx); b.st[0] = nloc; b.st[1] = nx; }
        const unsigned old = xb_add(&bar[XB_XSUB(b.x)], 1u);
        const unsigned gen = old / nloc;
        if (old + 1u == (gen + 1u) * nloc) {
            __builtin_amdgcn_fence(__ATOMIC_RELEASE, "agent");
            asm volatile("s_waitcnt vmcnt(0)" ::: "memory");
            const unsigned og = xb_add(&bar[XB_TOP], 1u);
            const unsigned tg = og / nx;
            if (og + 1u == (tg + 1u) * nx) xb_add(&bar[XB_TOPGEN], 1u);
            else XB_SPIN(xb_ld(&bar[XB_TOPGEN]) == tg, bar);
            __builtin_amdgcn_fence(__ATOMIC_ACQUIRE, "agent");
            xb_add(&bar[XB_XGEN(b.x)], 1u);
            asm volatile("s_waitcnt vmcnt(0)" ::: "memory");
        } else {
            XB_SPIN(xb_ld(&bar[XB_XGEN(b.x)]) == gen, bar);
            __builtin_amdgcn_fence(__ATOMIC_ACQUIRE, "agent");
            asm volatile("s_waitcnt vmcnt(0)" ::: "memory");
        }
    }
    __syncthreads();
}

struct Args { const float* in[21]; float* out; unsigned char* ws; };
enum { I_XP = 0, I_XS, I_PP, I_PS, I_SH, I_SP, I_GAINS, I_LB, I_GU1, I_D1, I_WIN, I_GN, I_WA, I_WPOOL, I_PSCALE, I_WB, I_WOUT, I_GU2, I_D2, I_WPP, I_WPG };

__global__ void __launch_bounds__(NTHR, 2) mega_fwd(Args a) {
    extern __shared__ __attribute__((aligned(16))) unsigned char lds_raw[];
    LAS unsigned char* lds = (LAS unsigned char*)lds_raw;
    cg::grid_group grid = cg::this_grid();
    const int tid = threadIdx.x, lane = tid & 63, wave = __builtin_amdgcn_readfirstlane(tid >> 6);
    const int G = gridDim.x, bx = blockIdx.x, vcu = (G % 8 == 0) ? (bx % 8) * (G / 8) + bx / 8 : bx;
    const int gw = vcu * NWAVES + wave, NGW = G * NWAVES;
    unsigned char* ws = a.ws; float* out = a.out;
    float* LB = (float*)(ws + WS_LB); float* EG = (float*)(ws + WS_EG);
    bf16_t* H = (bf16_t*)(ws + WS_H); bf16_t* Y = (bf16_t*)(ws + WS_Y); bf16_t* ACT = (bf16_t*)(ws + B_ACT);
    bf16_t *Qp = (bf16_t*)(ws + B_QP), *Kp = (bf16_t*)(ws + B_KP), *Vb = (bf16_t*)(ws + B_VB), *OG = (bf16_t*)(ws + B_OG), *Ob = (bf16_t*)(ws + B_O), *GA = (bf16_t*)(ws + B_GA), *GB = (bf16_t*)(ws + B_GB);
    bf16_t *Ub = (bf16_t*)(ws + WS_U), *POOLED = (bf16_t*)(ws + WS_POOLED), *PM = (bf16_t*)(ws + WS_PM), *Eb = (bf16_t*)(ws + B_E), *Pb = (bf16_t*)(ws + B_PB);
    const float* gains = a.in[I_GAINS];
    { volatile LAS unsigned* st0 = (volatile LAS unsigned*)(lds + 131072 + 256); if (tid < 2) st0[tid] = 0u; }
    __syncthreads();
    XcdBarrier xbar = xcd_barrier_post((unsigned*)(ws + WS_SS), (volatile LAS unsigned*)(lds + 131072 + 256));
    grid.sync();
#define GSYNC() xcd_barrier(xbar)
#define WT(off) ((bf16_t*)(ws + (off)))
    constexpr int NI_GU = 16 * 176, NI_D = 44 * 32, NI_IN = 16 * 208, NI_SQ = 16 * 32, NI_B = 8 * 32, NI_PP = 4 * 32;
    constexpr int NI_EARLY = NI_GU + NI_D + NI_IN, NITEMS = 2 * NI_GU + 2 * NI_D + NI_IN + 3 * NI_SQ + NI_B + NI_PP;
    constexpr int IT_D2 = NI_EARLY + NI_GU, IT_A = IT_D2 + NI_D, IT_PG = IT_A + 2 * NI_SQ, IT_B = IT_PG + NI_SQ, IT_PP = IT_B + NI_B;
#define CONVERT_ITEMS(lo_, hi_, gw_, ngw_) do { LAS float* scr_ = (LAS float*)(lds + wave * 16384); const int lane_ = otid() & 63; \
        for (int it = (lo_) + (gw_); it < (hi_); it += (ngw_)) { int r = it; const float* W; int K, N, kind = 0; bf16_t* dst; \
            if (r < NI_GU) { W = a.in[I_GU1]; K = 1024; N = 5632; dst = WT(W_GU1); kind = 1; } \
            else if ((r -= NI_GU) < NI_D) { W = a.in[I_D1]; K = 2816; N = 1024; dst = WT(W_D1); } \
            else if ((r -= NI_D) < NI_IN) { W = a.in[I_WIN]; K = 1024; N = 6656; dst = WT(W_IN); kind = 2; } \
            else if ((r -= NI_IN) < NI_GU) { W = a.in[I_GU2]; K = 1024; N = 5632; dst = WT(W_GU2); kind = 1; } \
            else if ((r -= NI_GU) < NI_D) { W = a.in[I_D2]; K = 2816; N = 1024; dst = WT(W_D2); } \
            else if ((r -= NI_D) < NI_SQ) { W = a.in[I_WA]; K = 1024; N = 1024; dst = WT(W_A); } \
            else if ((r -= NI_SQ) < NI_SQ) { W = a.in[I_WOUT]; K = 1024; N = 1024; dst = WT(W_OUT); } \
            else if ((r -= NI_SQ) < NI_SQ) { W = a.in[I_WPG]; K = 1024; N = 1024; dst = WT(W_PG); } \
            else if ((r -= NI_SQ) < NI_B) { W = a.in[I_WB]; K = 512; N = 1024; dst = WT(W_B); } \
            else { r -= NI_B; W = a.in[I_WPP]; K = 256; N = 1024; dst = WT(W_PP); } \
            const int nblk = N / 32, kb = r / nblk, nb = r % nblk, dn = nb * 32; \
            const int sn = kind == 1 ? map_gu(dn) : (kind == 2 ? map_in(dn) : dn); \
            transpose_item(W, N, sn, K, dst, dn, kb * 64, scr_, lane_); } } while (0)
#define SGW bx, G, wave, otid() & 63
#define GEMM(EpiT, E, Aptr, Btptr, N_, K_, nNp, pn0p, nNs, pn0s, rot) do { pg8::Gemm g_{(Aptr), (Btptr), M, (N_), (K_)}; TileSched S_; S_.init((nNp), (pn0p), (nNs), (pn0s), G, (bx + (rot)) % G); \
        pg8::gemm_phase<EpiT, TileSched, true, true>(lds, g_, S_, (E)); } while (0)

    {
        CONVERT_ITEMS(0, (G == 256) ? NI_GU : NI_EARLY, gw, NGW);
        const int gt = bx * NTHR + tid, NGT = G * NTHR;
        { const float* wp = a.in[I_WPOOL]; bf16_t* d = WT(W_POOL);
          for (int idx = gt; idx < 512 * 512 / 2; idx += NGT) { const int n = idx >> 8, k = (idx & 255) * 2, g1 = n >> 7, dd = n & 127, g2 = k >> 7, c = k & 127;
              float v0 = 0.f, v1 = 0.f; if (g1 == g2) { v0 = wp[(size_t)(g1 * 128 + c) * 128 + dd]; v1 = wp[(size_t)(g1 * 128 + c + 1) * 128 + dd]; }
              ((unsigned*)d)[idx] = pk2(v0, v1); } }
        for (int idx = gt; idx < 1024; idx += NGT) { const float l0 = a.in[I_LB][idx], l1 = a.in[I_LB][1024 + idx]; LB[idx] = 1.0f / (1.0f + __expf(l1 - l0)); }
        for (int m = gw; m < M; m += NGW) { const float* xr = (m < MP) ? a.in[I_XP] + (size_t)m * DM : a.in[I_XS] + (size_t)(m - MP) * DM; rms_row_to_bf16(xr, gains + 0 * DM, H + (size_t)m * DM, lane); }
    }
    GSYNC();
    { EpiSwiGLU E{ACT}; GEMM(EpiSwiGLU, E, H, WT(W_GU1), 5632, 1024, 22, 0, 22, 0, 0); }
    if (G == 256 && bx >= 150) {
        __syncthreads(); CONVERT_ITEMS(NI_GU, NI_EARLY, (bx - 150) * NWAVES + wave, 106 * NWAVES); }
    GSYNC();
    { EpiStore<false> E{Y, DM, nullptr}; GEMM(EpiStore<false>, E, ACT, WT(W_D1), 1024, DFF, 4, 0, 0, 0, 0); SStore ES{Y, DM, nullptr}; sgemm_sample(lds, ACT, WT(W_D1), 1024, DFF, ES, SGW);
    }
    GSYNC();
    row_phase<true>(Y, a.in[I_XP], a.in[I_XS], out + O_Y, H, gains + 1 * DM, 0.5f, gains + 2 * DM, gw, NGW, otid() & 63);
    GSYNC();
    { EpiIn E{ws, EG, LB}; GEMM(EpiIn, E, H, WT(W_IN), NIN, 1024, 14, 0, 26, 0, 0); }
    if (G == 256 && bx >= 154) {
        __syncthreads(); const int gw4 = (bx - 154) * NWAVES + wave;
        CONVERT_ITEMS(IT_A, IT_PG, gw4, 102 * NWAVES); CONVERT_ITEMS(IT_B, IT_PP, gw4, 102 * NWAVES);
        CONVERT_ITEMS(NI_EARLY, NI_EARLY + NI_GU, gw4, 102 * NWAVES); }
    GSYNC();
    hgrn_phase(lds, Qp, Kp, Vb, Ob, EG, a.in[I_SH], out + O_HP, out + O_HS, G, bx, otid());
    { const int half = (G >= 256) ? 128 : 0;
      if (bx >= half) { __syncthreads(); const int gw2 = (bx - half) * NWAVES + wave, ngw2 = (G - half) * NWAVES;
          if (G == 256) { CONVERT_ITEMS(IT_D2, IT_A, gw2, ngw2); CONVERT_ITEMS(IT_PG, IT_B, gw2, ngw2); CONVERT_ITEMS(IT_PP, NITEMS, gw2, ngw2); }
          else CONVERT_ITEMS(NI_EARLY, NITEMS, gw2, ngw2);
          prep_pool(Ub, POOLED, a.in[I_SP], out + O_PP, out + O_PS, gw2, ngw2, otid() & 63);
          asm volatile("s_waitcnt vmcnt(0)" ::: "memory"); __syncthreads();
          if (otid() == 0) { __builtin_amdgcn_fence(__ATOMIC_RELEASE, "agent"); asm volatile("s_waitcnt vmcnt(0)" ::: "memory");
              unsigned* cnt = (unsigned*)(ws + 14336); __hip_atomic_fetch_add(cnt, 1u, __ATOMIC_RELAXED, __HIP_MEMORY_SCOPE_AGENT);
              unsigned sp = 0; while (__hip_atomic_load(cnt, __ATOMIC_RELAXED, __HIP_MEMORY_SCOPE_AGENT) < (unsigned)(G - half)) { __builtin_amdgcn_s_sleep(2); if (++sp > (1u << 22)) break; }
              __builtin_amdgcn_fence(__ATOMIC_ACQUIRE, "agent"); asm volatile("s_waitcnt vmcnt(0)" ::: "memory"); }
          __syncthreads();
          { EpiStore<true> E{PM, BW, a.in[I_PSCALE]}; pg8::Gemm g_{POOLED, WT(W_POOL), M, 512, 512}; TileSched S_; S_.init(2, 0, 0, 0, G - half, bx - half);
            pg8::gemm_phase<EpiStore<true>, TileSched, true, true>(lds, g_, S_, E);
            SStore ES{PM, BW, a.in[I_PSCALE]}; sgemm_sample(lds, POOLED, WT(W_POOL), 512, 512, ES, bx - half, G - half, wave, otid() & 63); }
          __syncthreads();
          { EpiIn E{ws, EG, LB}; pg8::Gemm g_{H, WT(W_IN), M, NIN, 1024}; TileSched S_; S_.init(4, 14, 0, 0, G - half, bx - half);
            pg8::gemm_phase<EpiIn, TileSched, true, true>(lds, g_, S_, E); } } }
    GSYNC();
    if (bx & 1) prep_og(Ob, OG, a.in[I_GN], gw, NGW, otid() & 63);
    { EpiIn E{ws, EG, LB}; GEMM(EpiIn, E, H, WT(W_IN), NIN, 1024, 8, 18, 0, 0, 0); }
    if (!(bx & 1)) prep_og(Ob, OG, a.in[I_GN], gw, NGW, otid() & 63);
    GSYNC();
    {
        { EpiMulInPlace E{GA}; GEMM(EpiMulInPlace, E, OG, WT(W_A), 1024, 1024, 4, 0, 0, 0, 0); SMulInPlace ES{GA}; sgemm_sample(lds, OG, WT(W_A), 1024, 1024, ES, SGW); }
        { EpiFmaInPlace E{GA, GB}; GEMM(EpiFmaInPlace, E, PM, WT(W_B), 1024, 512, 4, 0, 0, 0, 0); SFmaInPlace ES{GA, GB}; sgemm_sample(lds, PM, WT(W_B), 1024, 512, ES, SGW); }
    }
    GSYNC();
    { EpiStore<false> E{Y, DM, nullptr};
      GEMM(EpiStore<false>, E, GB, WT(W_OUT), 1024, 1024, 4, 0, 0, 0, 0); { SStore ES{Y, DM, nullptr}; sgemm_sample(lds, GB, WT(W_OUT), 1024, 1024, ES, SGW); }
    }
    GSYNC();
    row_phase<true>(Y, out + O_Y, out + O_Y + (size_t)MP * DM, out + O_Y, H, gains + 3 * DM, 1.0f, gains + 4 * DM, gw, NGW, otid() & 63);
    GSYNC();
    { EpiSwiGLU E{ACT}; GEMM(EpiSwiGLU, E, H, WT(W_GU2), 5632, 1024, 22, 0, 22, 0, 0); }
    { const int first = (G == 256) ? 150 : 0;
      if (bx >= first) { const int gt = (bx - first) * NTHR + otid(), NGT = (G - first) * NTHR;
        for (int idx = gt; idx < M * PLE / 4; idx += NGT) { const int e = idx * 4; const float* src = (e < MP * PLE) ? a.in[I_PP] + e : a.in[I_PS] + (e - MP * PLE); const f32x4 v = *(const f32x4*)src;
            u32x2 w; w.x = pk2(v.x, v.y); w.y = pk2(v.z, v.w); ((u32x2*)Pb)[idx] = w; } } }
    GSYNC();
    { EpiStore<false> E{Y, DM, nullptr}; GEMM(EpiStore<false>, E, ACT, WT(W_D2), 1024, DFF, 4, 0, 0, 0, 0); SStore ES{Y, DM, nullptr}; sgemm_sample(lds, ACT, WT(W_D2), 1024, DFF, ES, SGW); }
    GSYNC();
    row_phase<true>(Y, out + O_Y, out + O_Y + (size_t)MP * DM, out + O_Y, H, gains + 5 * DM, 0.5f, gains + 6 * DM, gw, NGW, otid() & 63);
    GSYNC();
    { EpiStore<false> E{Eb, DM, nullptr}; GEMM(EpiStore<false>, E, Pb, WT(W_PP), 1024, PLE, 4, 0, 0, 0, 0); SStore ES{Eb, DM, nullptr}; sgemm_sample(lds, Pb, WT(W_PP), 1024, PLE, ES, SGW); }
    { EpiPleGate E{Eb, Y}; GEMM(EpiPleGate, E, H, WT(W_PG), 1024, 1024, 4, 0, 0, 0, 0); SPleGate ES{Eb, Y}; sgemm_sample(lds, H, WT(W_PG), 1024, 1024, ES, SGW); }
    GSYNC();
    row_phase<false>(Y, out + O_Y, out + O_Y + (size_t)MP * DM, out + O_Y, nullptr, gains + 7 * DM, 1.0f, nullptr, gw, NGW, otid() & 63);
#undef WT
#undef GEMM
}

extern "C" void kernel_launch(void* const* d_in, const int* in_sizes, int n_in, void* d_out, int out_size, void* d_ws, size_t ws_size, hipStream_t stream) {
    static int grid = 0;
    if (grid == 0) {
        if (n_in != 21 || in_sizes[0] != MP * DM || ws_size < WS_NEED) { fprintf(stderr, "kernel_launch: unexpected shapes (n_in %d, ws %zu, need %zu)\n", n_in, ws_size, (size_t)WS_NEED); grid = -1; return; }
        int dev = 0, cus = 0, per_cu = 0;
        hipGetDevice(&dev); hipDeviceGetAttribute(&cus, hipDeviceAttributeMultiprocessorCount, dev);
        hipFuncSetAttribute((const void*)mega_fwd, hipFuncAttributeMaxDynamicSharedMemorySize, LDS_BYTES);
        hipOccupancyMaxActiveBlocksPerMultiprocessor(&per_cu, (const void*)mega_fwd, NTHR, LDS_BYTES);
        if (per_cu < 1) { fprintf(stderr, "kernel_launch: occupancy query says %d blocks/CU\n", per_cu); per_cu = 1; }
        grid = cus;
        if (grid > 256) grid = 256;
        grid &= ~7;
    }
    if (grid <= 0) return;
    Args a{};
    for (int i = 0; i < 21; ++i) a.in[i] = (const float*)d_in[i];
    a.out = (float*)d_out; a.ws = (unsigned char*)d_ws;
    if (hipMemsetAsync(d_ws, 0, 16384, stream) != hipSuccess) { fprintf(stderr, "kernel_launch: memset failed\n"); return; }
    void* args[] = {&a};
    hipError_t e = hipLaunchCooperativeKernel((const void*)mega_fwd, dim3(grid), dim3(NTHR), args, LDS_BYTES, stream);
    if (e != hipSuccess) fprintf(stderr, "kernel_launch: cooperative launch failed: %s (grid %d)\n", hipGetErrorString(e), grid);
}
```

```cpp
#include <hip/hip_runtime.h>
#include <hip/hip_cooperative_groups.h>
#include <cstdio>
#include <cstdint>
namespace cg = cooperative_groups;
namespace pg8 {
#define PG8_LAS __attribute__((address_space(3)))
typedef unsigned short bf16_t;
typedef short bf16x8 __attribute__((ext_vector_type(8)));
typedef float f32x4 __attribute__((ext_vector_type(4)));
typedef unsigned u32x4 __attribute__((ext_vector_type(4)));
constexpr int BM = 256, BK = 64, HALF = 128, HTB = HALF * BK * 2  , STAGE_BYTES = 8 * HTB, NXCD = 8, WGM = 8;

__host__ __device__ __forceinline__ int lds_byte(int r, int c) { const int st = (r >> 4) * 2 + (c >> 5), rr = r & 15, cc = c & 31, ob = rr * 64 + cc * 2; return st * 1024 + (ob ^ (((ob >> 9) & 1) << 5)); }
__host__ __device__ __forceinline__ void stage_rc(int b, int& R, int& C) { const int st = b / 1024, sb = b % 1024, swz = sb ^ (((sb >> 9) & 1) << 5); R = (st >> 1) * 16 + swz / 64; C = (st & 1) * 32 + (swz % 64) / 2; }
__host__ __device__ __forceinline__ int perm32(int rho) { const int n = rho >> 4, i = rho & 15; return 8 * (i >> 2) + 4 * n + (i & 3); }

struct Unit { int pm, pn; };
struct Gemm { const bf16_t* A; const bf16_t* Bt; int M, N, K; };

struct StaticOrder {
    int nM, nN, nwg, G, c;
    __host__ __device__ void init(int M, int N, int G_, int c_) { nM = M / BM; nN = N / BM; nwg = nM * nN; G = G_; c = c_; }
    __host__ __device__ bool next(int i, Unit& u) const {
        const long L = (long)i * G + c; if (L >= nwg) return false;
        int wgid = (int)L; { const int q = nwg / NXCD, r = nwg % NXCD, xcd = wgid % NXCD, off = wgid / NXCD; wgid = (xcd < r ? xcd * (q + 1) : r * (q + 1) + (xcd - r) * q) + off; }
        const int nig = WGM * nN, gid = wgid / nig, fm = gid * WGM, gsz = (nM - fm) < WGM ? (nM - fm) : WGM;
        u.pm = fm + ((wgid % nig) % gsz); u.pn = (wgid % nig) / gsz; return true;
    }
    __device__ __forceinline__ void a_ready(const Unit&) const {}
    __device__ __forceinline__ void done(const Unit&) const {}
};

__device__ __forceinline__ unsigned cvt_pk_bf16(float lo, float hi) { unsigned r; asm volatile("v_cvt_pk_bf16_f32 %0, %1, %2" : "=v"(r) : "v"(lo), "v"(hi)); return r; }
typedef float f32x2 __attribute__((ext_vector_type(2)));
template <class Epi, class Sched, bool ALIGN_EPI = false, bool SP2 = false>
__device__ __forceinline__ void gemm_phase(PG8_LAS unsigned char* lds, const Gemm g, const Sched& S, const Epi& E) {
    int tid_ = threadIdx.x; asm volatile("" : "+v"(tid_));
    const int tid = tid_, wid = __builtin_amdgcn_readfirstlane(tid >> 6), lane = tid & 63, wr = wid >> 2, wc = wid & 3, fr = lane & 15, fq = lane >> 4;
    const int K = g.K, nt = K / BK;
    unsigned voffA[2], voffB[2];
#pragma unroll
    for (int i = 0; i < 2; ++i) { int R, C; stage_rc(tid * 16 + i * 8192, R, C); const int Rb = Epi::PERM ? ((R & ~31) + perm32(R & 31)) : R;
        voffA[i] = (unsigned)(R * K + C) * 2u; voffB[i] = (unsigned)(Rb * K + C) * 2u; }
    const size_t kstep = (size_t)(BK * 2);
    const size_t hstep = (size_t)HALF * K * 2;
    const size_t tstep = 2 * hstep;
    const unsigned ldsw = (unsigned)wid * 1024u;
    const int aoff = lds_byte(wr * 64 + fr, fq * 8), boff = lds_byte(wc * 32 + fr, fq * 8);
#define PG8_SA(b, h) (((b) * 2 + (h)) * HTB)
#define PG8_SB(b, h) ((4 + (b) * 2 + (h)) * HTB)
#define PG8_STAGE(bufoff, gbase, voff) do { _Pragma("unroll") for (int _i = 0; _i < 2; ++_i) \
        __builtin_amdgcn_global_load_lds((const unsigned*)((const char*)(gbase) + (voff)[_i]), (PG8_LAS unsigned*)(lds + (bufoff) + ldsw + _i * 8192), 16, 0, 0); } while (0)
#define PG8_LDA(dst, b, h) do { _Pragma("unroll") for (int m = 0; m < 4; ++m) _Pragma("unroll") for (int k = 0; k < 2; ++k) dst[m][k] = *(const PG8_LAS bf16x8*)(lds + PG8_SA(b, h) + aoff + m * 2048 + k * 1024); } while (0)
#define PG8_LDB(dst, b, h) do { _Pragma("unroll") for (int n = 0; n < 2; ++n) _Pragma("unroll") for (int k = 0; k < 2; ++k) dst[n][k] = *(const PG8_LAS bf16x8*)(lds + PG8_SB(b, h) + boff + n * 2048 + k * 1024); } while (0)
#define PG8_MMA(ai, bj, At, Bt) do { __builtin_amdgcn_s_setprio(1); _Pragma("unroll") for (int m = 0; m < 4; ++m) _Pragma("unroll") for (int n = 0; n < 2; ++n) _Pragma("unroll") for (int k = 0; k < 2; ++k) \
        acc[ai][bj][m][n] = __builtin_amdgcn_mfma_f32_16x16x32_bf16(Bt[n][k], At[m][k], acc[ai][bj][m][n], 0, 0, 0); __builtin_amdgcn_s_setprio(0); } while (0)
#define PG8_WAIT_V(n) asm volatile("s_waitcnt vmcnt(" #n ")" ::: "memory")
#define PG8_WAIT_L(n) asm volatile("s_waitcnt lgkmcnt(" #n ")" ::: "memory")
#define PG8_BAR __builtin_amdgcn_s_barrier()
#define PG8_SCHED __builtin_amdgcn_sched_barrier(0)
    Unit cur, nxt; int ui = 0;
    if (!S.next(0, cur)) return;
    f32x4 acc[2][2][4][2];
#pragma unroll
    for (int a = 0; a < 2; ++a)
#pragma unroll
        for (int b = 0; b < 2; ++b)
#pragma unroll
            for (int m = 0; m < 4; ++m)
#pragma unroll
                for (int n = 0; n < 2; ++n) acc[a][b][m][n] = (f32x4){0.f, 0.f, 0.f, 0.f};
    bf16x8 At[4][2], B0[2][2], B1[2][2];
    const char* cA = (const char*)g.A + (size_t)cur.pm * tstep; const char* cB = (const char*)g.Bt + (size_t)cur.pn * tstep;
    S.a_ready(cur);
    if constexpr (SP2) {
        PG8_STAGE(PG8_SB(0, 0), cB, voffB); PG8_STAGE(PG8_SB(0, 1), cB + hstep, voffB); PG8_STAGE(PG8_SA(0, 0), cA, voffA); PG8_STAGE(PG8_SA(0, 1), cA + hstep, voffA);
        if (wr == 1) PG8_BAR;
        PG8_WAIT_V(2); PG8_BAR;
        PG8_STAGE(PG8_SB(1, 0), cB + kstep, voffB); PG8_STAGE(PG8_SA(1, 0), cA + kstep, voffA); PG8_STAGE(PG8_SB(1, 1), cB + hstep + kstep, voffB);
        PG8_WAIT_V(6); PG8_BAR;
    } else {
        PG8_STAGE(PG8_SB(0, 0), cB, voffB); PG8_STAGE(PG8_SA(0, 0), cA, voffA); PG8_STAGE(PG8_SB(0, 1), cB + hstep, voffB); PG8_STAGE(PG8_SA(0, 1), cA + hstep, voffA);
        if (wr == 1) PG8_BAR;
        PG8_WAIT_V(4); PG8_BAR;
        PG8_STAGE(PG8_SB(1, 0), cB + kstep, voffB); PG8_STAGE(PG8_SA(1, 0), cA + kstep, voffA); PG8_STAGE(PG8_SB(1, 1), cB + hstep + kstep, voffB);
        PG8_WAIT_V(6); PG8_BAR;
    }
    for (;;) {
        const bool has_next = S.next(ui + 1, nxt);
        const char* nA = has_next ? (const char*)g.A + (size_t)nxt.pm * tstep : cA; const char* nB = has_next ? (const char*)g.Bt + (size_t)nxt.pn * tstep : cB;
        for (int t = 0; t < nt; t += 2) {
            const bool last = (t == nt - 2);
            const char* a1 = cA + (size_t)(t + 1) * kstep;
            const char* a2 = last ? nA : cA + (size_t)(t + 2) * kstep; const char* b2 = last ? nB : cB + (size_t)(t + 2) * kstep;
            const char* a3 = a2 + kstep; const char* b3 = b2 + kstep;
            if (last && has_next) S.a_ready(nxt);
            if constexpr (SP2) {
            PG8_LDB(B0, 0, 0); PG8_LDB(B1, 0, 1); PG8_SCHED; PG8_LDA(At, 0, 0); PG8_STAGE(PG8_SA(1, 1), a1 + hstep, voffA);
            PG8_WAIT_V(8); PG8_WAIT_L(0); PG8_BAR; PG8_MMA(0, 0, At, B0); PG8_MMA(0, 1, At, B1); PG8_BAR; PG8_SCHED;
            PG8_LDA(At, 0, 1); PG8_STAGE(PG8_SB(0, 0), b2, voffB); PG8_STAGE(PG8_SB(0, 1), b2 + hstep, voffB); PG8_STAGE(PG8_SA(0, 0), a2, voffA);
            PG8_WAIT_V(8); PG8_WAIT_L(0); PG8_BAR; PG8_MMA(1, 0, At, B0); PG8_MMA(1, 1, At, B1); PG8_BAR; PG8_SCHED;
            PG8_LDB(B0, 1, 0); PG8_LDB(B1, 1, 1); PG8_SCHED; PG8_LDA(At, 1, 0); PG8_STAGE(PG8_SA(0, 1), a2 + hstep, voffA);
            PG8_WAIT_V(8); PG8_WAIT_L(0); PG8_BAR; PG8_MMA(0, 0, At, B0); PG8_MMA(0, 1, At, B1); PG8_BAR; PG8_SCHED;
            PG8_LDA(At, 1, 1); PG8_STAGE(PG8_SB(1, 0), b3, voffB); PG8_STAGE(PG8_SB(1, 1), b3 + hstep, voffB); PG8_STAGE(PG8_SA(1, 0), a3, voffA);
            PG8_WAIT_V(8); PG8_WAIT_L(0); PG8_BAR; PG8_MMA(1, 0, At, B0); PG8_MMA(1, 1, At, B1); PG8_BAR; PG8_SCHED;
            } else {
            PG8_LDB(B0, 0, 0); PG8_SCHED; PG8_LDA(At, 0, 0); PG8_STAGE(PG8_SA(1, 1), a1 + hstep, voffA);
            PG8_WAIT_L(8); PG8_BAR; PG8_WAIT_L(0); PG8_MMA(0, 0, At, B0); PG8_BAR; PG8_SCHED;
            PG8_LDB(B1, 0, 1); PG8_STAGE(PG8_SB(0, 0), b2, voffB);
            PG8_BAR; PG8_WAIT_L(0); PG8_MMA(0, 1, At, B1); PG8_BAR;
            PG8_LDA(At, 0, 1); PG8_STAGE(PG8_SA(0, 0), a2, voffA);
            PG8_BAR; PG8_WAIT_L(0); PG8_MMA(1, 0, At, B0); PG8_BAR; PG8_SCHED;
            PG8_STAGE(PG8_SB(0, 1), b2 + hstep, voffB);
            PG8_WAIT_V(6); PG8_BAR; PG8_MMA(1, 1, At, B1); PG8_BAR;
            PG8_LDB(B0, 1, 0); PG8_SCHED; PG8_LDA(At, 1, 0); PG8_STAGE(PG8_SA(0, 1), a2 + hstep, voffA);
            PG8_WAIT_L(8); PG8_BAR; PG8_WAIT_L(0); PG8_MMA(0, 0, At, B0); PG8_BAR; PG8_SCHED;
            PG8_LDB(B1, 1, 1); PG8_STAGE(PG8_SB(1, 0), b3, voffB);
            PG8_BAR; PG8_WAIT_L(0); PG8_MMA(0, 1, At, B1); PG8_BAR;
            PG8_LDA(At, 1, 1); PG8_STAGE(PG8_SA(1, 0), a3, voffA);
            PG8_BAR; PG8_WAIT_L(0); PG8_MMA(1, 0, At, B0); PG8_BAR; PG8_SCHED;
            PG8_STAGE(PG8_SB(1, 1), b3 + hstep, voffB);
            PG8_WAIT_V(6); PG8_BAR; PG8_MMA(1, 1, At, B1); PG8_BAR;
            }
        }
        if constexpr (ALIGN_EPI) { if (wr == 0) PG8_BAR; }
        if constexpr (!Epi::AFTER_DRAIN) { E(acc, cur, wr, wc, fr, fq); S.done(cur); }
        if (!has_next) break;
#pragma unroll
        for (int a = 0; a < 2; ++a)
#pragma unroll
            for (int b = 0; b < 2; ++b)
#pragma unroll
                for (int m = 0; m < 4; ++m)
#pragma unroll
                    for (int n = 0; n < 2; ++n) acc[a][b][m][n] = (f32x4){0.f, 0.f, 0.f, 0.f};
        cur = nxt; cA = nA; cB = nB; ++ui;
        if constexpr (ALIGN_EPI) { if (wr == 1) PG8_BAR; }
    }
    PG8_WAIT_V(0);
    if constexpr (!ALIGN_EPI) { if (wr == 0) PG8_BAR; }
    PG8_BAR;
    if constexpr (Epi::AFTER_DRAIN) { E.fused(acc, cur, wr, wc, fr, fq, lds, wid, lane); S.done(cur); }
#undef PG8_SA
#undef PG8_SB
#undef PG8_STAGE
#undef PG8_LDA
#undef PG8_LDB
#undef PG8_MMA
#undef PG8_WAIT_V
#undef PG8_WAIT_L
#undef PG8_BAR
#undef PG8_SCHED
}
}

#define LAS __attribute__((address_space(3)))
using pg8::bf16_t; using pg8::bf16x8; using pg8::f32x4; using pg8::u32x4; using pg8::Unit;
typedef float f32x2_t __attribute__((ext_vector_type(2))); typedef __bf16 bf16x2_t __attribute__((ext_vector_type(2)));
__device__ __forceinline__ unsigned cvt_pk_bf16(float lo, float hi) { f32x2_t v = {lo, hi}; bf16x2_t b = __builtin_convertvector(v, bf16x2_t); return __builtin_bit_cast(unsigned, b); }
typedef unsigned u32x2 __attribute__((ext_vector_type(2)));
typedef short s16x4 __attribute__((ext_vector_type(4)));
constexpr int DM = 1024, MP = 16384, MS = 256, M = MP + MS, DFF = 2816, NIN = 6656, BW = 512, PLE = 256;
constexpr int SEQ = 8192, DSEQ = 32, PAST = 2048, NB_P = 2, NB_S = 8;
constexpr float EPS = 1e-6f;
constexpr int NWAVES = 8, NTHR = 512;
constexpr int LDS_BYTES = 147456;

constexpr size_t MiB = 1u << 20;
constexpr size_t U1 = (size_t)M * 1024 * 2;
constexpr size_t WS_SS = 0, WS_LB = 1 * MiB, WS_EG = 2 * MiB, WS_W = 4 * MiB;
constexpr size_t W_GU1 = WS_W, W_D1 = W_GU1 + (size_t)5632 * 1024 * 2, W_IN = W_D1 + (size_t)1024 * 2816 * 2, W_A = W_IN + (size_t)6656 * 1024 * 2,
                 W_POOL = W_A + (size_t)1024 * 1024 * 2, W_B = W_POOL + (size_t)512 * 512 * 2, W_OUT = W_B + (size_t)1024 * 512 * 2, W_GU2 = W_OUT + (size_t)1024 * 1024 * 2,
                 W_D2 = W_GU2 + (size_t)5632 * 1024 * 2, W_PP = W_D2 + (size_t)1024 * 2816 * 2, W_PG = W_PP + (size_t)1024 * 256 * 2, W_END = W_PG + (size_t)1024 * 1024 * 2;
constexpr size_t WS_H = 59 * MiB, WS_Y = WS_H + U1, WS_BIG = WS_Y + U1;
constexpr size_t B_QP = WS_BIG, B_KP = WS_BIG + 33 * MiB, B_VB = WS_BIG + 66 * MiB, B_O = B_VB  , B_OG = WS_BIG + 99 * MiB, B_GA = B_QP + MiB / 2, B_GB = B_KP + MiB / 2;
constexpr size_t B_ACT = WS_BIG, B_E = WS_BIG, B_PB = W_GU1  ;
constexpr size_t WS_U = WS_Y, WS_POOLED = WS_Y + (size_t)M * 512 * 2, WS_PM = W_GU1  ;
constexpr size_t WS_NEED = B_OG + U1;
static_assert(W_END <= WS_H && WS_NEED <= 256 * MiB && (size_t)M * DFF * 2 <= 131 * MiB && U1 <= 33 * MiB - MiB / 2, "d_ws map");
constexpr size_t O_Y = 0, O_HP = (size_t)M * DM, O_PP = O_HP + (size_t)NB_P * 8 * 128 * 128, O_HS = O_PP + (size_t)NB_P * 15 * 512, O_PS = O_HS + (size_t)NB_S * 8 * 128 * 128;

__device__ __forceinline__ float bf2f(unsigned short v) { return __uint_as_float((unsigned)v << 16); }
__device__ __forceinline__ float bflo(unsigned w) { return __uint_as_float(w << 16); }
__device__ __forceinline__ float bfhi(unsigned w) { return __uint_as_float(w & 0xffff0000u); }
__device__ __forceinline__ f32x4 zero_acc() { f32x4 z = (f32x4){0.f, 0.f, 0.f, 0.f}; asm volatile("" : "+v"(z)); return z; }
__device__ __forceinline__ int otid() { int t = threadIdx.x; asm volatile("" : "+v"(t)); return t; }
__device__ __forceinline__ float fexp(float x) { return __builtin_amdgcn_exp2f(x * 1.44269504f); }
__device__ __forceinline__ float flog(float x) { return __builtin_amdgcn_logf(x) * 0.69314718f; }
__device__ __forceinline__ float frcp(float x) { return __builtin_amdgcn_rcpf(x); }
__device__ __forceinline__ float sigm(float x) { return frcp(1.0f + fexp(-x)); }
__device__ __forceinline__ float wave_sum(float v) {
#pragma unroll
    for (int o = 1; o < 64; o <<= 1) v += __shfl_xor(v, o);
    return v;
}
template <int CTRL> __device__ __forceinline__ float dppm(float x) { return __int_as_float(__builtin_amdgcn_update_dpp(0x3f800000, __float_as_int(x), CTRL, 0xf, 0xf, false)); }
template <int CTRL> __device__ __forceinline__ float dppf(float x) { return __int_as_float(__builtin_amdgcn_update_dpp(0, __float_as_int(x), CTRL, 0xf, 0xf, true)); }

struct TileSched {
    int nNp, pn0p, nNs, pn0s, nwgP, G, c;
    __device__ __forceinline__ void init(int nNp_, int pn0p_, int nNs_, int pn0s_, int G_, int c_) { nNp = nNp_; pn0p = pn0p_; nNs = nNs_; pn0s = pn0s_; nwgP = 64 * nNp_; G = G_; c = c_; }
    __device__ __forceinline__ bool next(int i, Unit& u) const {
        long L = (long)i * G + c;
        if (L < nwgP) {
            int wgid = (int)L; { const int q = nwgP / 8, xcd = wgid % 8, off = wgid / 8; wgid = xcd * q + off; }
            const int nig = 8 * nNp, gid = wgid / nig, fm = gid * 8;
            u.pm = fm + ((wgid % nig) % 8); u.pn = pn0p + (wgid % nig) / 8; return true;
        }
        L -= nwgP;
        if (L < nNs) { u.pm = 64; u.pn = pn0s + (int)L; return true; }
        return false;
    }
    __device__ __forceinline__ void a_ready(const Unit&) const {}
    __device__ __forceinline__ void done(const Unit&) const {}
};

#define EPI_ROWS(ai, m) (u.pm * 256 + (ai) * 128 + wr * 64 + (m) * 16 + fr)
__device__ __forceinline__ u32x4 pack8(const f32x4& a, const f32x4& b) { u32x4 w; w.x = cvt_pk_bf16(a[0], a[1]); w.y = cvt_pk_bf16(a[2], a[3]); w.z = cvt_pk_bf16(b[0], b[1]); w.w = cvt_pk_bf16(b[2], b[3]); return w; }
__device__ __forceinline__ void unpack8(const u32x4& w, f32x4& a, f32x4& b) { a = (f32x4){bflo(w.x), bfhi(w.x), bflo(w.y), bfhi(w.y)}; b = (f32x4){bflo(w.z), bfhi(w.z), bflo(w.w), bfhi(w.w)}; }

struct EpiSwiGLU {
    static constexpr bool PERM = true, AFTER_DRAIN = false;
    bf16_t* O;
    __device__ __forceinline__ void operator()(f32x4 (&acc)[2][2][4][2], const Unit& u, int wr, int wc, int fr, int fq) const {
        const int col0 = u.pn * 128 + wc * 32 + 8 * fq;
#pragma unroll
        for (int ai = 0; ai < 2; ++ai)
#pragma unroll
            for (int m = 0; m < 4; ++m) {
                f32x4 o[2];
#pragma unroll
                for (int n = 0; n < 2; ++n)
#pragma unroll
                    for (int j = 0; j < 4; ++j) { const float a = acc[ai][0][m][n][j], b = acc[ai][1][m][n][j]; o[n][j] = a * sigm(a) * b; }
                *(u32x4*)(O + (size_t)EPI_ROWS(ai, m) * DFF + col0) = pack8(o[0], o[1]);
            }
    }
};
template <bool SCALE> struct EpiStore {
    static constexpr bool PERM = true, AFTER_DRAIN = false;
    bf16_t* O; int ldc; const float* scale;
    __device__ __forceinline__ void operator()(f32x4 (&acc)[2][2][4][2], const Unit& u, int wr, int wc, int fr, int fq) const {
#pragma unroll
        for (int bj = 0; bj < 2; ++bj) {
            const int col0 = u.pn * 256 + bj * 128 + wc * 32 + 8 * fq;
            f32x4 s0 = (f32x4){1.f, 1.f, 1.f, 1.f}, s1 = s0;
            if (SCALE) { s0 = *(const f32x4*)(scale + col0); s1 = *(const f32x4*)(scale + col0 + 4); }
#pragma unroll
            for (int ai = 0; ai < 2; ++ai)
#pragma unroll
                for (int m = 0; m < 4; ++m) *(u32x4*)(O + (size_t)EPI_ROWS(ai, m) * ldc + col0) = pack8(acc[ai][bj][m][0] * s0, acc[ai][bj][m][1] * s1);
        }
    }
};
struct EpiMulInPlace {
    static constexpr bool PERM = true, AFTER_DRAIN = false;
    bf16_t* Gt;
    __device__ __forceinline__ void operator()(f32x4 (&acc)[2][2][4][2], const Unit& u, int wr, int wc, int fr, int fq) const {
#pragma unroll
        for (int bj = 0; bj < 2; ++bj) {
            const int col0 = u.pn * 256 + bj * 128 + wc * 32 + 8 * fq;
#pragma unroll
            for (int ai = 0; ai < 2; ++ai)
#pragma unroll
                for (int m = 0; m < 4; ++m) { bf16_t* p = Gt + (size_t)EPI_ROWS(ai, m) * DM + col0; f32x4 g0, g1; unpack8(*(const u32x4*)p, g0, g1);
                    *(u32x4*)p = pack8(g0 * acc[ai][bj][m][0], g1 * acc[ai][bj][m][1]); }
        }
    }
};
struct EpiFmaInPlace {
    static constexpr bool PERM = true, AFTER_DRAIN = false;
    const bf16_t* T1; bf16_t* Gb;
    __device__ __forceinline__ void operator()(f32x4 (&acc)[2][2][4][2], const Unit& u, int wr, int wc, int fr, int fq) const {
#pragma unroll
        for (int bj = 0; bj < 2; ++bj) {
            const int col0 = u.pn * 256 + bj * 128 + wc * 32 + 8 * fq;
#pragma unroll
            for (int ai = 0; ai < 2; ++ai)
#pragma unroll
                for (int m = 0; m < 4; ++m) { const size_t off = (size_t)EPI_ROWS(ai, m) * DM + col0; f32x4 g0, g1, t0, t1; unpack8(*(const u32x4*)(Gb + off), g0, g1); unpack8(*(const u32x4*)(T1 + off), t0, t1);
                    *(u32x4*)(Gb + off) = pack8(t0 + g0 * acc[ai][bj][m][0], t1 + g1 * acc[ai][bj][m][1]); }
        }
    }
};
struct EpiPleGate {
    static constexpr bool PERM = true, AFTER_DRAIN = false;
    const bf16_t* E; bf16_t* O;
    __device__ __forceinline__ void operator()(f32x4 (&acc)[2][2][4][2], const Unit& u, int wr, int wc, int fr, int fq) const {
#pragma unroll
        for (int bj = 0; bj < 2; ++bj) {
            const int col0 = u.pn * 256 + bj * 128 + wc * 32 + 8 * fq;
#pragma unroll
            for (int ai = 0; ai < 2; ++ai)
#pragma unroll
                for (int m = 0; m < 4; ++m) { const size_t off = (size_t)EPI_ROWS(ai, m) * DM + col0; f32x4 e0, e1; unpack8(*(const u32x4*)(E + off), e0, e1); f32x4 o0, o1;
#pragma unroll
                    for (int j = 0; j < 4; ++j) { o0[j] = sigm(acc[ai][bj][m][0][j]) * e0[j]; o1[j] = sigm(acc[ai][bj][m][1][j]) * e1[j]; }
                    *(u32x4*)(O + off) = pack8(o0, o1); }
        }
    }
};
struct EpiIn {
    static constexpr bool PERM = true, AFTER_DRAIN = false;
    unsigned char* ws; float* EG; const float* lb;
    __device__ __forceinline__ void operator()(f32x4 (&acc)[2][2][4][2], const Unit& u, int wr, int wc, int fr, int fq) const {
        const int cin = wc * 32 + 8 * fq;
        bf16_t* Qp = (bf16_t*)(ws + B_QP); bf16_t* Kp = (bf16_t*)(ws + B_KP);
        if (u.pn < 8) {
            const int h = u.pn; const bool smp = (u.pm == 64);
            const f32x4 lb0 = *(const f32x4*)(lb + h * 128 + cin), lb1 = *(const f32x4*)(lb + h * 128 + cin + 4);
#pragma unroll
            for (int ai = 0; ai < 2; ++ai) {
                f32x4 egA[2], egB[2];
#pragma unroll
                for (int n = 0; n < 2; ++n)
#pragma unroll
                    for (int j = 0; j < 4; ++j) {
                        const float lbv = n ? lb1[j] : lb0[j], omlb = 1.0f - lbv;
                        float inc[4], tot[4], kk[4];
#pragma unroll
                        for (int m = 0; m < 4; ++m) {
                            float fz = acc[ai][1][m][n][j]; fz = fminf(fmaxf(fz, -30.f), 30.f);
                            const float e = fexp(-fz), sg = frcp(1.0f + e);
                            kk[m] = omlb * e * sg;
                            float x = lbv + omlb * sg;
                            x *= dppm<0x111>(x); x *= dppm<0x112>(x); x *= dppm<0x114>(x); x *= dppm<0x118>(x);
                            inc[m] = x; tot[m] = dppf<0x15F>(x);
                        }
                        const float off1 = tot[0], off2 = smp ? 1.f : tot[0] * tot[1], off3 = off2 * tot[2];
                        const float lastA = smp ? tot[0] * tot[1] : off3 * tot[3], lastB = tot[2] * tot[3];
                        const float g[4] = {inc[0], inc[1] * off1, inc[2] * off2, inc[3] * off3};
#pragma unroll
                        for (int m = 0; m < 4; ++m) {
                            const float q = acc[ai][0][m][n][j];
                            const float eg_ = g[m], d_ = 1.0f + fexp(-fmaxf(q, -30.f)), r_ = frcp(d_ * eg_);
                            acc[ai][0][m][n][j] = (q * eg_) * (eg_ * r_);
                            acc[ai][1][m][n][j] = kk[m] * (d_ * r_);
                        }
                        egA[n][j] = lastA; egB[n][j] = lastB;
                    }
#pragma unroll
                for (int m = 0; m < 4; ++m) { const size_t off = (size_t)EPI_ROWS(ai, m) * DM + h * 128 + cin;
                    *(u32x4*)(Qp + off) = pack8(acc[ai][0][m][0], acc[ai][0][m][1]); *(u32x4*)(Kp + off) = pack8(acc[ai][1][m][0], acc[ai][1][m][1]); }
                if (fr == 0) {
                    if (!smp) { float* p = EG + (size_t)(u.pm * 4 + ai * 2 + wr) * 1024 + h * 128 + cin; *(f32x4*)p = egA[0]; *(f32x4*)(p + 4) = egA[1]; }
                    else { float* p = EG + (size_t)(256 + ai * 4 + wr * 2) * 1024 + h * 128 + cin; *(f32x4*)p = egA[0]; *(f32x4*)(p + 4) = egA[1]; *(f32x4*)(p + 1024) = egB[0]; *(f32x4*)(p + 1028) = egB[1]; }
                }
            }
            return;
        }
        size_t boff; int ldc, c0, act;
        if (u.pn < 12) { boff = B_VB; ldc = 1024; c0 = (u.pn - 8) * 256; act = 0; }
        else if (u.pn < 14) { boff = WS_U; ldc = 512; c0 = (u.pn - 12) * 256; act = 0; }
        else if (u.pn < 18) { boff = B_OG; ldc = 1024; c0 = (u.pn - 14) * 256; act = 1; }
        else if (u.pn < 22) { boff = B_GA; ldc = 1024; c0 = (u.pn - 18) * 256; act = 2; }
        else { boff = B_GB; ldc = 1024; c0 = (u.pn - 22) * 256; act = 2; }
        bf16_t* O = (bf16_t*)(ws + boff);
#pragma unroll
        for (int bj = 0; bj < 2; ++bj)
#pragma unroll
            for (int ai = 0; ai < 2; ++ai)
#pragma unroll
                for (int m = 0; m < 4; ++m) {
                    f32x4 o[2];
#pragma unroll
                    for (int n = 0; n < 2; ++n)
#pragma unroll
                        for (int j = 0; j < 4; ++j) { const float x = acc[ai][bj][m][n][j]; const float s = sigm(x); o[n][j] = act == 0 ? x : (act == 1 ? x * s : s); }
                    *(u32x4*)(O + (size_t)EPI_ROWS(ai, m) * ldc + c0 + bj * 128 + cin) = pack8(o[0], o[1]);
                }
    }
};

__device__ __forceinline__ u32x2 pack4(const f32x4& a) { u32x2 w; w.x = cvt_pk_bf16(a[0], a[1]); w.y = cvt_pk_bf16(a[2], a[3]); return w; }
__device__ __forceinline__ f32x4 unpack4(const u32x2& w) { return (f32x4){bflo(w.x), bfhi(w.x), bflo(w.y), bfhi(w.y)}; }
struct SStore { bf16_t* O; int ldc; const float* scale;
    __device__ __forceinline__ void operator()(int row, int col, f32x4 v) const { if (scale) v = v * *(const f32x4*)(scale + col); *(u32x2*)(O + (size_t)row * ldc + col) = pack4(v); } };
struct SMulInPlace { bf16_t* Gt;
    __device__ __forceinline__ void operator()(int row, int col, f32x4 v) const { bf16_t* p = Gt + (size_t)row * DM + col; *(u32x2*)p = pack4(unpack4(*(const u32x2*)p) * v); } };
struct SFmaInPlace { const bf16_t* T1; bf16_t* Gb;
    __device__ __forceinline__ void operator()(int row, int col, f32x4 v) const { const size_t off = (size_t)row * DM + col; *(u32x2*)(Gb + off) = pack4(unpack4(*(const u32x2*)(T1 + off)) + unpack4(*(const u32x2*)(Gb + off)) * v); } };
struct SPleGate { const bf16_t* E; bf16_t* O;
    __device__ __forceinline__ void operator()(int row, int col, f32x4 v) const { const size_t off = (size_t)row * DM + col; const f32x4 e = unpack4(*(const u32x2*)(E + off)); f32x4 o;
#pragma unroll
        for (int j = 0; j < 4; ++j) o[j] = sigm(v[j]) * e[j];
        *(u32x2*)(O + off) = pack4(o); } };
template <class Epi> __device__ __forceinline__ void sgemm_sample(LAS unsigned char* lds, const bf16_t* A, const bf16_t* Bt, int N, int K, const Epi& E, int bx, int G, int wave, int lane) {
    const int fr = lane & 15, fq = lane >> 4, nblk = N >> 2, per = K >> 8;
    LAS f32x4* slots = (LAS f32x4*)lds;
    for (int bt = bx; bt < nblk; bt += G) {
        const int rb = bt & 7, cb = bt >> 3;
        const bf16_t* ap = A + (size_t)(MP + 32 * rb + fr) * K + 32 * (wave * per) + 8 * fq;
        const bf16_t* bp = Bt + (size_t)(32 * cb + fr) * K + 32 * (wave * per) + 8 * fq;
        const size_t r16 = (size_t)16 * K;
        f32x4 acc00 = zero_acc(), acc01 = zero_acc(), acc10 = zero_acc(), acc11 = zero_acc();
        for (int s0 = 0; s0 < per; s0 += 4) {
            bf16x8 a0[4], a1[4], b0[4], b1[4];
#pragma unroll
            for (int u = 0; u < 4; ++u) { const int su = (s0 + u < per) ? s0 + u : per - 1;
                a0[u] = *(const bf16x8*)(ap + 32 * su); a1[u] = *(const bf16x8*)(ap + r16 + 32 * su); b0[u] = *(const bf16x8*)(bp + 32 * su); b1[u] = *(const bf16x8*)(bp + r16 + 32 * su); }
#pragma unroll
            for (int u = 0; u < 4; ++u) { if (s0 + u < per) {
                acc00 = __builtin_amdgcn_mfma_f32_16x16x32_bf16(b0[u], a0[u], acc00, 0, 0, 0); acc01 = __builtin_amdgcn_mfma_f32_16x16x32_bf16(b1[u], a0[u], acc01, 0, 0, 0);
                acc10 = __builtin_amdgcn_mfma_f32_16x16x32_bf16(b0[u], a1[u], acc10, 0, 0, 0); acc11 = __builtin_amdgcn_mfma_f32_16x16x32_bf16(b1[u], a1[u], acc11, 0, 0, 0); } }
        }
        __syncthreads();
        slots[(wave * 4 + 0) * 64 + lane] = acc00; slots[(wave * 4 + 1) * 64 + lane] = acc01; slots[(wave * 4 + 2) * 64 + lane] = acc10; slots[(wave * 4 + 3) * 64 + lane] = acc11;
        __syncthreads();
        if (wave < 4) {
            f32x4 sum = slots[(0 * 4 + wave) * 64 + lane];
#pragma unroll
            for (int w = 1; w < 8; ++w) sum = sum + slots[(w * 4 + wave) * 64 + lane];
            const int i = wave >> 1, j = wave & 1;
            E(MP + 32 * rb + 16 * i + fr, 32 * cb + 16 * j + 4 * fq, sum);
        }
    }
    __syncthreads();
}

__device__ __forceinline__ unsigned pk2(float lo, float hi) { return cvt_pk_bf16(lo, hi); }
__device__ __forceinline__ void transpose_item(const float* W, int ldn, int src_n0, int K, bf16_t* WT, int dst_n0, int k0, LAS float* scr, int lane) {
    const int nq = (lane & 7) * 4, kr = lane >> 3;
    f32x4 v[8];
#pragma unroll
    for (int i = 0; i < 8; ++i) v[i] = __builtin_nontemporal_load((const f32x4*)(W + (size_t)(k0 + 8 * i + kr) * ldn + src_n0 + nq));
#pragma unroll
    for (int i = 0; i < 8; ++i) { LAS float* d = scr + (8 * i + kr) * 33 + nq; d[0] = v[i].x; d[1] = v[i].y; d[2] = v[i].z; d[3] = v[i].w; }
    asm volatile("s_waitcnt lgkmcnt(0)" ::: "memory");
    const int c = lane & 7;
#pragma unroll
    for (int j = 0; j < 4; ++j) { const int n = (lane >> 3) + 8 * j; const LAS float* s = scr + (8 * c) * 33 + n;
        u32x4 o; o.x = pk2(s[0 * 33], s[1 * 33]); o.y = pk2(s[2 * 33], s[3 * 33]); o.z = pk2(s[4 * 33], s[5 * 33]); o.w = pk2(s[6 * 33], s[7 * 33]);
        *(u32x4*)(WT + (size_t)(dst_n0 + n) * K + k0 + 8 * c) = o; }
    asm volatile("s_waitcnt lgkmcnt(0)" ::: "memory");
}
__device__ __forceinline__ int map_gu(int n) { const int pn = n >> 8, bj = (n >> 7) & 1, jj = n & 127; return bj * DFF + pn * 128 + jj; }
__device__ __forceinline__ int map_in(int n) {
    if (n < 2048) { const int h = n >> 8, bj = (n >> 7) & 1, kk = n & 127; return bj * 1024 + h * 128 + kk; }
    if (n < 3072) return n;
    if (n < 3584) return 4096 + (n - 3072);
    if (n < 4608) return 3072 + (n - 3584);
    return n;
}
__device__ __forceinline__ void rms_row_to_bf16(const float* xrow, const float* g, bf16_t* orow, int lane) {
    const f32x4* xr = (const f32x4*)xrow + lane; f32x4 v[4]; float s = 0.f;
#pragma unroll
    for (int j = 0; j < 4; ++j) { v[j] = __builtin_nontemporal_load(xr + 64 * j); s += (v[j].x * v[j].x + v[j].y * v[j].y) + (v[j].z * v[j].z + v[j].w * v[j].w); }
    const float r = rsqrtf(wave_sum(s) * (1.f / 1024.f) + EPS);
    u32x2* o8 = (u32x2*)orow + lane;
#pragma unroll
    for (int j = 0; j < 4; ++j) { const f32x4 gg = ((const f32x4*)g)[lane + 64 * j]; u32x2 w; w.x = pk2(v[j].x * r * gg.x, v[j].y * r * gg.y); w.y = pk2(v[j].z * r * gg.z, v[j].w * r * gg.w); o8[64 * j] = w; }
}
template <bool HAS_H> __device__ __forceinline__ void row_phase(const bf16_t* Y, const float* xin_p, const float* xin_s, float* xout, bf16_t* H, const float* g_post, float coef, const float* g_pre, int gw, int NGW, int lane) {
    for (int m = gw; m < M; m += NGW) {
        const float* xi = (m < MP) ? xin_p + (size_t)m * DM : xin_s + (size_t)(m - MP) * DM;
        const u32x2* yr = (const u32x2*)(Y + (size_t)m * DM) + lane; f32x4 y[4], x[4]; float s = 0.f;
#pragma unroll
        for (int j = 0; j < 4; ++j) { const u32x2 w = __builtin_nontemporal_load(yr + 64 * j); y[j] = (f32x4){bflo(w.x), bfhi(w.x), bflo(w.y), bfhi(w.y)}; x[j] = __builtin_nontemporal_load((const f32x4*)xi + lane + 64 * j);
            s += (y[j].x * y[j].x + y[j].y * y[j].y) + (y[j].z * y[j].z + y[j].w * y[j].w); }
        const float r = rsqrtf(wave_sum(s) * (1.f / 1024.f) + EPS) * coef; float s2 = 0.f;
#pragma unroll
        for (int j = 0; j < 4; ++j) { const f32x4 gg = ((const f32x4*)g_post)[lane + 64 * j]; x[j] = x[j] + y[j] * gg * r; __builtin_nontemporal_store(x[j], (f32x4*)(xout + (size_t)m * DM) + lane + 64 * j);
            s2 += (x[j].x * x[j].x + x[j].y * x[j].y) + (x[j].z * x[j].z + x[j].w * x[j].w); }
        if (HAS_H) {
            const float r2 = rsqrtf(wave_sum(s2) * (1.f / 1024.f) + EPS); u32x2* o8 = (u32x2*)(H + (size_t)m * DM) + lane;
#pragma unroll
            for (int j = 0; j < 4; ++j) { const f32x4 gg = ((const f32x4*)g_pre)[lane + 64 * j]; u32x2 w; w.x = pk2(x[j].x * r2 * gg.x, x[j].y * r2 * gg.y); w.y = pk2(x[j].z * r2 * gg.z, x[j].w * r2 * gg.w); o8[64 * j] = w; }
        }
    }
}

constexpr int HP = 136, L_QKBUF = 2 * 64 * HP * 2, L_KOFF = 64 * HP * 2, L_VT = 2 * L_QKBUF, L_VTSZ = 16 * 72 * 2, L_AL = L_VT + 2 * L_VTSZ, L_ALSZ = 64 * 72 * 2, L_ST = L_AL + 2 * L_ALSZ, L_STSZ = 16 * HP * 2;
static_assert(L_ST + 2 * L_STSZ <= 131072, "hgrn lds");
#define HG_LOAD2(c, RQ, RK, RV, EGN) do { _Pragma("unroll") for (int j_ = 0; j_ < 2; ++j_) { const int row_ = prow0 + 32 * j_, rowc_ = row_ < T ? row_ : T - 1; const size_t go_ = (size_t)(row0 + (c) * 64 + rowc_) * DM + qcol + pch * 8; \
            RQ[j_] = *(const u32x4*)(Qp + go_); RK[j_] = *(const u32x4*)(Kp + go_); } \
            { const int vrc_ = vrow < T ? vrow : T - 1; RV = *(const u32x4*)(Vb + (size_t)(row0 + (c) * 64 + vrc_) * DM + vcol + vhalf * 8); } \
            EGN = *(const f32x4*)(EG + (size_t)(cid0 + (c)) * 1024 + h * 128 + 16 * wave + 4 * fq); } while (0)
#define HG_WRITE2(bf, RQ, RK, RV) do { LAS unsigned char* qb_ = lds + (bf) * L_QKBUF; _Pragma("unroll") for (int j_ = 0; j_ < 2; ++j_) { const int row_ = prow0 + 32 * j_; const bool z_ = row_ >= T; \
            u32x4 q_ = RQ[j_], k_ = RK[j_]; if (z_) { q_ = (u32x4){0u, 0u, 0u, 0u}; k_ = q_; } \
            *(LAS u32x4*)(qb_ + (row_ * HP + pch * 8) * 2) = q_; *(LAS u32x4*)(qb_ + L_KOFF + (row_ * HP + pch * 8) * 2) = k_; } \
            if (tid < 128) { u32x4 v_ = RV; if (vrow >= T) v_ = (u32x4){0u, 0u, 0u, 0u}; LAS unsigned short* vt_ = (LAS unsigned short*)(lds + L_VT + (bf) * L_VTSZ) + (vhalf * 8) * 72 + vrow; \
                vt_[0 * 72] = (unsigned short)v_.x; vt_[1 * 72] = (unsigned short)(v_.x >> 16); vt_[2 * 72] = (unsigned short)v_.y; vt_[3 * 72] = (unsigned short)(v_.y >> 16); \
                vt_[4 * 72] = (unsigned short)v_.z; vt_[5 * 72] = (unsigned short)(v_.z >> 16); vt_[6 * 72] = (unsigned short)v_.w; vt_[7 * 72] = (unsigned short)(v_.w >> 16); } } while (0)
#define HG_STEP(cc) do { const int c_ = (cc); const int bf = c_ & 1; \
            if (wave < 4) __builtin_amdgcn_s_setprio(2);   \
            if (wave < 4 && c_ > 0) { \
                const LAS unsigned char* ALp = lds + L_AL + (bf ^ 1) * L_ALSZ; \
                const int tt = wave, nks = (tt >> 1) + 1; \
                { const bf16x8 af = *(const LAS bf16x8*)(ALp + ((16 * tt + fr) * 72 + 8 * fq) * 2); oprev = __builtin_amdgcn_mfma_f32_16x16x32_bf16(vprev0, af, oprev, 0, 0, 0); } \
                if (nks > 1) { const bf16x8 af = *(const LAS bf16x8*)(ALp + ((16 * tt + fr) * 72 + 32 + 8 * fq) * 2); oprev = __builtin_amdgcn_mfma_f32_16x16x32_bf16(vprev1, af, oprev, 0, 0, 0); } \
                const int t = 16 * tt + fr; \
                if (t < T) { const size_t grow = (size_t)(row0 + (c_ - 1) * 64 + t); u32x2 w; w.x = pk2(oprev[0], oprev[1]); w.y = pk2(oprev[2], oprev[3]); *(u32x2*)(Ob + grow * DM + vcol + 4 * fq) = w; } \
            } \
            if (c_ < nch) { \
            const LAS unsigned char* QL = lds + bf * L_QKBUF; const LAS unsigned char* KL = QL + L_KOFF; const LAS unsigned char* VT = lds + L_VT + bf * L_VTSZ; \
            const LAS unsigned char* STo = lds + L_ST + bf * L_STSZ; LAS unsigned char* STn = lds + L_ST + (bf ^ 1) * L_STSZ; LAS unsigned char* AL = lds + L_AL + bf * L_ALSZ; \
            f32x4 oacc = zero_acc(); \
            if (wave < 4) { \
                const int tt = wave; bf16x8 qf[4]; \
_Pragma("unroll") \
                for (int ks = 0; ks < 4; ++ks) qf[ks] = *(const LAS bf16x8*)(QL + ((16 * tt + fr) * HP + 32 * ks + 8 * fq) * 2); \
                f32x4 a = zero_acc(); \
_Pragma("unroll") \
                for (int ks = 0; ks < 4; ++ks) { const bf16x8 kf = *(const LAS bf16x8*)(KL + ((16 * tt + fr) * HP + 32 * ks + 8 * fq) * 2); a = __builtin_amdgcn_mfma_f32_16x16x32_bf16(kf, qf[ks], a, 0, 0, 0); } \
_Pragma("unroll") \
                for (int i = 0; i < 4; ++i) if (4 * fq + i > fr) a[i] = 0.f; \
                { u32x2 w; w.x = pk2(a[0], a[1]); w.y = pk2(a[2], a[3]); *(LAS u32x2*)(AL + ((16 * tt + fr) * 72 + 16 * tt + 4 * fq) * 2) = w; } \
_Pragma("unroll") \
                for (int ks = 0; ks < 4; ++ks) { const bf16x8 sf = *(const LAS bf16x8*)(STo + (fr * HP + 32 * ks + 8 * fq) * 2); oacc = __builtin_amdgcn_mfma_f32_16x16x32_bf16(sf, qf[ks], oacc, 0, 0, 0); } \
            } else { \
                if (wave == 4) { bf16x8 kf[4];   \
_Pragma("unroll") \
                    for (int ks = 0; ks < 4; ++ks) kf[ks] = *(const LAS bf16x8*)(KL + (fr * HP + 32 * ks + 8 * fq) * 2); \
_Pragma("unroll") \
                    for (int tt = 1; tt < 3; ++tt) { f32x4 a = zero_acc(); \
_Pragma("unroll") \
                        for (int ks = 0; ks < 4; ++ks) { const bf16x8 qf = *(const LAS bf16x8*)(QL + ((16 * tt + fr) * HP + 32 * ks + 8 * fq) * 2); a = __builtin_amdgcn_mfma_f32_16x16x32_bf16(kf[ks], qf, a, 0, 0, 0); } \
                        u32x2 w; w.x = pk2(a[0], a[1]); w.y = pk2(a[2], a[3]); *(LAS u32x2*)(AL + ((16 * tt + fr) * 72 + 4 * fq) * 2) = w; } \
                } else if (wave == 5) { bf16x8 qf[4];   \
_Pragma("unroll") \
                    for (int ks = 0; ks < 4; ++ks) qf[ks] = *(const LAS bf16x8*)(QL + ((48 + fr) * HP + 32 * ks + 8 * fq) * 2); \
_Pragma("unroll") \
                    for (int st = 0; st < 2; ++st) { f32x4 a = zero_acc(); \
_Pragma("unroll") \
                        for (int ks = 0; ks < 4; ++ks) { const bf16x8 kf = *(const LAS bf16x8*)(KL + ((16 * st + fr) * HP + 32 * ks + 8 * fq) * 2); a = __builtin_amdgcn_mfma_f32_16x16x32_bf16(kf, qf[ks], a, 0, 0, 0); } \
                        u32x2 w; w.x = pk2(a[0], a[1]); w.y = pk2(a[2], a[3]); *(LAS u32x2*)(AL + ((48 + fr) * 72 + 16 * st + 4 * fq) * 2) = w; } \
                } else { const int tt = (wave == 6) ? 2 : 3, st = tt - 1;   \
                    f32x4 a = zero_acc(); \
_Pragma("unroll") \
                    for (int ks = 0; ks < 4; ++ks) { const bf16x8 kf = *(const LAS bf16x8*)(KL + ((16 * st + fr) * HP + 32 * ks + 8 * fq) * 2); const bf16x8 qf = *(const LAS bf16x8*)(QL + ((16 * tt + fr) * HP + 32 * ks + 8 * fq) * 2); \
                        a = __builtin_amdgcn_mfma_f32_16x16x32_bf16(kf, qf, a, 0, 0, 0); } \
                    u32x2 w; w.x = pk2(a[0], a[1]); w.y = pk2(a[2], a[3]); *(LAS u32x2*)(AL + ((16 * tt + fr) * 72 + 16 * st + 4 * fq) * 2) = w; \
                } \
            } \
            bf16x8 vf[2]; \
_Pragma("unroll") \
            for (int ks = 0; ks < 2; ++ks) vf[ks] = *(const LAS bf16x8*)(VT + (fr * 72 + 32 * ks + 8 * fq) * 2); \
            {   \
              const unsigned ka_ = (unsigned)(__UINTPTR_TYPE__)KL + (unsigned)((8 * fq + (fr >> 2)) * (HP * 2) + 32 * wave + 8 * (fr & 3)); \
              s16x4 k00, k01, k10, k11; \
              asm volatile("ds_read_b64_tr_b16 %0, %4\n\tds_read_b64_tr_b16 %1, %4 offset:%5\n\tds_read_b64_tr_b16 %2, %4 offset:%6\n\tds_read_b64_tr_b16 %3, %4 offset:%7\n\ts_waitcnt lgkmcnt(0)" \
                           : "=&v"(k00), "=&v"(k01), "=&v"(k10), "=&v"(k11) : "v"(ka_), "n"(4 * HP * 2), "n"(32 * HP * 2), "n"(36 * HP * 2) : "memory"); \
              const bf16x8 kt0 = __builtin_shufflevector(k00, k01, 0, 1, 2, 3, 4, 5, 6, 7), kt1 = __builtin_shufflevector(k10, k11, 0, 1, 2, 3, 4, 5, 6, 7); \
              S = __builtin_amdgcn_mfma_f32_16x16x32_bf16(kt0, vf[0], S, 0, 0, 0); S = __builtin_amdgcn_mfma_f32_16x16x32_bf16(kt1, vf[1], S, 0, 0, 0); } \
            { S = S * eg; \
              u32x2 w; w.x = pk2(S[0], S[1]); w.y = pk2(S[2], S[3]); *(LAS u32x2*)(STn + (fr * HP + 16 * wave + 4 * fq) * 2) = w; } \
            oprev = oacc; vprev0 = vf[0]; vprev1 = vf[1]; \
            } \
            __builtin_amdgcn_s_setprio(0); \
        } while (0)
__device__ __forceinline__ void hgrn_phase(LAS unsigned char* lds, const bf16_t* Qp, const bf16_t* Kp, const bf16_t* Vb, bf16_t* Ob, const float* EG, const float* state_in, float* out_hp, float* out_hs, int G, int bx, int tid) {
    const int wave = __builtin_amdgcn_readfirstlane(tid >> 6), lane = tid & 63, fr = lane & 15, fq = lane >> 4;
    for (int i = tid; i < 2 * 64 * 72 / 2; i += NTHR) ((LAS unsigned*)(lds + L_AL))[i] = 0u;
    for (int item = bx; item < 640; item += G) {
        int b, h, slice, row0, nch, T, cid0; const float* S0; float* Sout;
        if (item < 128) { const int seq = item & 15; slice = item >> 4; b = seq >> 3; h = seq & 7; row0 = b * SEQ; nch = SEQ / 64; T = 64; cid0 = b * (SEQ / 64); S0 = nullptr; Sout = out_hp + (size_t)(b * 8 + h) * 16384; }
        else { const int j = item - 128, seq = j & 63; slice = j >> 6; b = seq >> 3; h = seq & 7; row0 = MP + b * DSEQ; nch = 1; T = DSEQ; cid0 = 256 + b; S0 = state_in + (size_t)(b * 8 + h) * 16384; Sout = out_hs + (size_t)(b * 8 + h) * 16384; }
        const int qcol = h * 128, vcol = h * 128 + slice * 16;
        f32x4 S;
#pragma unroll
        for (int i = 0; i < 4; ++i) S[i] = S0 ? S0[(size_t)(16 * wave + 4 * fq + i) * 128 + slice * 16 + fr] : 0.f;
        __syncthreads();
        { u32x2 w; w.x = pk2(S[0], S[1]); w.y = pk2(S[2], S[3]); *(LAS u32x2*)(lds + L_ST + (fr * HP + 16 * wave + 4 * fq) * 2) = w; }
        u32x4 rq[2], rk[2], rv;
        const int prow0 = tid >> 4, pch = tid & 15;
#define HG_LOAD(c) do { _Pragma("unroll") for (int j_ = 0; j_ < 2; ++j_) { const int row_ = prow0 + 32 * j_, rowc_ = row_ < T ? row_ : T - 1; const size_t go_ = (size_t)(row0 + (c) * 64 + rowc_) * DM + qcol + pch * 8; \
            rq[j_] = *(const u32x4*)(Qp + go_); rk[j_] = *(const u32x4*)(Kp + go_); } \
            { const int vrc_ = vrow < T ? vrow : T - 1; rv = *(const u32x4*)(Vb + (size_t)(row0 + (c) * 64 + vrc_) * DM + vcol + vhalf * 8); } \
            egn = *(const f32x4*)(EG + (size_t)(cid0 + (c)) * 1024 + h * 128 + 16 * wave + 4 * fq); } while (0)
#define HG_WRITE(bf) do { LAS unsigned char* qb_ = lds + (bf) * L_QKBUF; _Pragma("unroll") for (int j_ = 0; j_ < 2; ++j_) { const int row_ = prow0 + 32 * j_; const bool z_ = row_ >= T; \
            u32x4 q_ = rq[j_], k_ = rk[j_]; if (z_) { q_ = (u32x4){0u, 0u, 0u, 0u}; k_ = q_; } \
            *(LAS u32x4*)(qb_ + (row_ * HP + pch * 8) * 2) = q_; *(LAS u32x4*)(qb_ + L_KOFF + (row_ * HP + pch * 8) * 2) = k_; } \
            if (tid < 128) { u32x4 v_ = rv; if (vrow >= T) v_ = (u32x4){0u, 0u, 0u, 0u}; LAS unsigned short* vt_ = (LAS unsigned short*)(lds + L_VT + (bf) * L_VTSZ) + (vhalf * 8) * 72 + vrow; \
                vt_[0 * 72] = (unsigned short)v_.x; vt_[1 * 72] = (unsigned short)(v_.x >> 16); vt_[2 * 72] = (unsigned short)v_.y; vt_[3 * 72] = (unsigned short)(v_.y >> 16); \
                vt_[4 * 72] = (unsigned short)v_.z; vt_[5 * 72] = (unsigned short)(v_.z >> 16); vt_[6 * 72] = (unsigned short)v_.w; vt_[7 * 72] = (unsigned short)(v_.w >> 16); } } while (0)
        f32x4 egn, eg;
        const int vrow = (tid & 127) >> 1, vhalf = tid & 1;
        u32x4 rqB[2], rkB[2], rvB; f32x4 egB;
#define CLAMPC(x) ((x) < nch ? (x) : nch - 1)
        HG_LOAD2(0, rq, rk, rv, egn); HG_WRITE2(0, rq, rk, rv); eg = egn;
        HG_LOAD2(CLAMPC(1), rq, rk, rv, egn);
        f32x4 oprev = zero_acc(); bf16x8 vprev0 = (bf16x8){0, 0, 0, 0, 0, 0, 0, 0}, vprev1 = vprev0;
        for (int c = 0; c <= nch; c += 2) {
            HG_LOAD2(CLAMPC(c + 2), rqB, rkB, rvB, egB);
            __syncthreads();
            HG_STEP(c);
            HG_WRITE2(1, rq, rk, rv); eg = egn;
            if (c + 1 > nch) break;
            HG_LOAD2(CLAMPC(c + 3), rq, rk, rv, egn);
            __syncthreads();
            HG_STEP(c + 1);
            HG_WRITE2(0, rqB, rkB, rvB); eg = egB;
        }
#undef CLAMPC
#pragma unroll
        for (int i = 0; i < 4; ++i) Sout[(size_t)(16 * wave + 4 * fq + i) * 128 + slice * 16 + fr] = S[i];
#undef HG_LOAD
#undef HG_WRITE
    }
}

__device__ __forceinline__ void prep_og(const bf16_t* Ob, bf16_t* OG, const float* gn, int gw, int NGW, int lane) {
    for (int m = gw; m < M; m += NGW) {
#pragma unroll
        for (int j = 0; j < 2; ++j) {
            const int col = lane * 8 + 512 * j;
            f32x4 o0, o1, g0, g1; unpack8(__builtin_nontemporal_load((const u32x4*)(Ob + (size_t)m * DM + col)), o0, o1); unpack8(*(const u32x4*)(OG + (size_t)m * DM + col), g0, g1);
            float ssq = (o0.x * o0.x + o0.y * o0.y) + (o0.z * o0.z + o0.w * o0.w) + (o1.x * o1.x + o1.y * o1.y) + (o1.z * o1.z + o1.w * o1.w);
            ssq += __shfl_xor(ssq, 1); ssq += __shfl_xor(ssq, 2); ssq += __shfl_xor(ssq, 4); ssq += __shfl_xor(ssq, 8);
            const float rs = rsqrtf(ssq * (1.f / 128.f) + EPS);
            const f32x4 n0 = *(const f32x4*)(gn + (col & 127)), n1 = *(const f32x4*)(gn + (col & 127) + 4);
            *(u32x4*)(OG + (size_t)m * DM + col) = pack8(o0 * n0 * g0 * rs, o1 * n1 * g1 * rs);
        }
    }
}
__device__ __forceinline__ void pool_row(const bf16_t* Ub, bf16_t* POOLED, const float* state_pool, float* out_pp, float* out_ps, int m, int lane) {
    int t, pos, TL; const float* buf; float* po;
    if (m < MP) { const int b = m / SEQ; t = m % SEQ; pos = t; TL = SEQ; buf = nullptr; po = out_pp + (size_t)b * 15 * 512; }
    else { const int b = (m - MP) / DSEQ; t = (m - MP) % DSEQ; pos = PAST + t; TL = DSEQ; buf = state_pool + (size_t)b * 15 * 512; po = out_ps + (size_t)b * 15 * 512; }
    const int col = lane * 8, w = 2 << (lane >> 4);
    f32x4 s0 = (f32x4){0.f, 0.f, 0.f, 0.f}, s1 = s0, u0 = s0, u1 = s0;
    for (int jj = 0; jj < w; ++jj) {
        const int tt = t - jj; f32x4 a0, a1;
        if (tt >= 0) unpack8(*(const u32x4*)(Ub + (size_t)(m - jj) * BW + col), a0, a1);
        else if (buf) { a0 = *(const f32x4*)(buf + (size_t)(15 + tt) * 512 + col); a1 = *(const f32x4*)(buf + (size_t)(15 + tt) * 512 + col + 4); }
        else { a0 = (f32x4){0.f, 0.f, 0.f, 0.f}; a1 = a0; }
        if (jj == 0) { u0 = a0; u1 = a1; }
        s0 = s0 + a0; s1 = s1 + a1;
    }
    const float ic = 1.0f / (float)((pos + 1 < w) ? pos + 1 : w);
    *(u32x4*)(POOLED + (size_t)m * BW + col) = pack8(s0 * ic - u0, s1 * ic - u1);
    if (t >= TL - 15) { float* p = po + (size_t)(t - (TL - 15)) * 512 + col; *(f32x4*)p = u0; *(f32x4*)(p + 4) = u1; }
}
__device__ __forceinline__ void prep_pool(const bf16_t* Ub, bf16_t* POOLED, const float* state_pool, float* out_pp, float* out_ps, int gw, int NGW, int lane) {
    const int col = lane * 8, w = 2 << (lane >> 4); const float ic = 1.0f / (float)w;
    for (int m0 = gw; m0 < M; m0 += 2 * NGW) {
        const int m1 = m0 + NGW; const bool two = m1 < M;
        const int t0 = (m0 < MP) ? m0 % SEQ : (m0 - MP) % DSEQ, t1 = two ? ((m1 < MP) ? m1 % SEQ : (m1 - MP) % DSEQ) : 0;
        if (two && t0 >= 15 && t1 >= 15) {
            u32x4 r0[16], r1[16];
#pragma unroll
            for (int jj = 0; jj < 16; ++jj) { r0[jj] = (u32x4){0u, 0u, 0u, 0u}; r1[jj] = r0[jj];
                if (jj < w) { r0[jj] = *(const u32x4*)(Ub + (size_t)(m0 - jj) * BW + col); r1[jj] = *(const u32x4*)(Ub + (size_t)(m1 - jj) * BW + col); } }
#pragma unroll
            for (int h = 0; h < 2; ++h) {
                const int m = h ? m1 : m0, t = h ? t1 : t0;
                f32x4 s0 = (f32x4){0.f, 0.f, 0.f, 0.f}, s1 = s0, u0 = s0, u1 = s0;
#pragma unroll
                for (int jj = 0; jj < 16; ++jj) { f32x4 a0, a1; unpack8(h ? r1[jj] : r0[jj], a0, a1); s0 = s0 + a0; s1 = s1 + a1; if (jj == 0) { u0 = a0; u1 = a1; } }
                *(u32x4*)(POOLED + (size_t)m * BW + col) = pack8(s0 * ic - u0, s1 * ic - u1);
                const int TL = (m < MP) ? SEQ : DSEQ;
                if (t >= TL - 15) { float* po = (m < MP) ? out_pp + (size_t)(m / SEQ) * 15 * 512 : out_ps + (size_t)((m - MP) / DSEQ) * 15 * 512;
                    float* p = po + (size_t)(t - (TL - 15)) * 512 + col; *(f32x4*)p = u0; *(f32x4*)(p + 4) = u1; }
            }
        } else { pool_row(Ub, POOLED, state_pool, out_pp, out_ps, m0, lane); if (two) pool_row(Ub, POOLED, state_pool, out_pp, out_ps, m1, lane); }
    }
}

typedef __attribute__((address_space(1))) unsigned gu32;
#define XB_TMO      128
#define XB_XCNT(j)  (256  + 64 * (j))
#define XB_XSUB(j)  (1280 + 64 * (j))
#define XB_XGEN(j)  (2304 + 64 * (j))
#define XB_TOP      3328
#define XB_TOPGEN   3392
#define XCD_BAR_WORDS 3456
#define XB_SPIN_CAP (1u << 18)

__device__ __forceinline__ unsigned xb_ld(unsigned* p)              { return __hip_atomic_load(p, __ATOMIC_RELAXED, __HIP_MEMORY_SCOPE_AGENT); }
__device__ __forceinline__ unsigned xb_add(unsigned* p, unsigned v) { return __hip_atomic_fetch_add(p, v, __ATOMIC_RELAXED, __HIP_MEMORY_SCOPE_AGENT); }
__device__ __forceinline__ unsigned xb_xcc_id() { return (unsigned)__builtin_amdgcn_s_getreg((3 << 11) | 20) & 0xFu; }
#define XB_SPIN(cond, bar) do { unsigned _sp = 0; while (cond) { __builtin_amdgcn_s_sleep(1); \
    if ((++_sp & 255u) == 0u) { if (xb_ld(&(bar)[XB_TMO])) break; if (_sp > XB_SPIN_CAP) { atomicAdd(&(bar)[XB_TMO], 1u); break; } } } } while (0)

struct XcdBarrier {
    unsigned* bar; unsigned x;
    volatile LAS unsigned* st;
};

__device__ __forceinline__ XcdBarrier xcd_barrier_post(unsigned* bar, volatile LAS unsigned* st) {
    XcdBarrier b; b.bar = bar; b.x = xb_xcc_id(); b.st = st;
    if (threadIdx.x == 0) (void)xb_add(&bar[XB_XCNT(b.x)], 1u);
    return b;
}
__device__ __forceinline__ void xcd_barrier_complete(unsigned* bar, unsigned x, unsigned& nloc, unsigned& nx) {
    const unsigned G = gridDim.x * gridDim.y * gridDim.z;
    unsigned sum, cnt, mine, sp = 0u;
    for (;;) {
        sum = 0u; cnt = 0u; mine = 0u;
#pragma unroll
        for (unsigned j = 0; j < 16; ++j) { const unsigned c = xb_ld(&bar[XB_XCNT(j)]); sum += c; cnt += (c > 0u) ? 1u : 0u; mine = (j == x) ? c : mine; }
        if (sum == G) break;
        __builtin_amdgcn_s_sleep(1);
        if ((++sp & 255u) == 0u) { if (xb_ld(&bar[XB_TMO])) break; if (sp > XB_SPIN_CAP) { atomicAdd(&bar[XB_TMO], 1u); break; } }
    }
    nloc = mine > 0u ? mine : 1u; nx = cnt > 0u ? cnt : 1u;
}

__device__ __forceinline__ void xcd_barrier(const XcdBarrier& b) {
    asm volatile("s_waitcnt vmcnt(0)" ::: "memory");
    __syncthreads();
    if (threadIdx.x == 0) {
        unsigned* bar = b.bar;
        __builtin_amdgcn_s_waitcnt(0);
        unsigned nloc = b.st[0], nx = b.st[1];
        if (nloc == 0u) { xcd_barrier_complete(bar, b.x, nloc, nx); b.st[0] = nloc; b.st[1] = nx; }
        const unsigned old = xb_add(&bar[XB_XSUB(b.x)], 1u);
        const unsigned gen = old / nloc;
        if (old + 1u == (gen + 1u) * nloc) {
            __builtin_amdgcn_fence(__ATOMIC_RELEASE, "agent");
            asm volatile("s_waitcnt vmcnt(0)" ::: "memory");
            const unsigned og = xb_add(&bar[XB_TOP], 1u);
            const unsigned tg = og / nx;
            if (og + 1u == (tg + 1u) * nx) xb_add(&bar[XB_TOPGEN], 1u);
            else XB_SPIN(xb_ld(&bar[XB_TOPGEN]) == tg, bar);
            __builtin_amdgcn_fence(__ATOMIC_ACQUIRE, "agent");
            xb_add(&bar[XB_XGEN(b.x)], 1u);
            asm volatile("s_waitcnt vmcnt(0)" ::: "memory");
        } else {
            XB_SPIN(xb_ld(&bar[XB_XGEN(b.x)]) == gen, bar);
            __builtin_amdgcn_fence(__ATOMIC_ACQUIRE, "agent");
            asm volatile("s_waitcnt vmcnt(0)" ::: "memory");
        }
    }
    __syncthreads();
}

struct Args { const float* in[21]; float* out; unsigned char* ws; };
enum { I_XP = 0, I_XS, I_PP, I_PS, I_SH, I_SP, I_GAINS, I_LB, I_GU1, I_D1, I_WIN, I_GN, I_WA, I_WPOOL, I_PSCALE, I_WB, I_WOUT, I_GU2, I_D2, I_WPP, I_WPG };

__global__ void __launch_bounds__(NTHR, 2) mega_fwd(Args a) {
    extern __shared__ __attribute__((aligned(16))) unsigned char lds_raw[];
    LAS unsigned char* lds = (LAS unsigned char*)lds_raw;
    cg::grid_group grid = cg::this_grid();
    const int tid = threadIdx.x, lane = tid & 63, wave = __builtin_amdgcn_readfirstlane(tid >> 6);
    const int G = gridDim.x, bx = blockIdx.x, vcu = (G % 8 == 0) ? (bx % 8) * (G / 8) + bx / 8 : bx;
    const int gw = vcu * NWAVES + wave, NGW = G * NWAVES;
    unsigned char* ws = a.ws; float* out = a.out;
    float* LB = (float*)(ws + WS_LB); float* EG = (float*)(ws + WS_EG);
    bf16_t* H = (bf16_t*)(ws + WS_H); bf16_t* Y = (bf16_t*)(ws + WS_Y); bf16_t* ACT = (bf16_t*)(ws + B_ACT);
    bf16_t *Qp = (bf16_t*)(ws + B_QP), *Kp = (bf16_t*)(ws + B_KP), *Vb = (bf16_t*)(ws + B_VB), *OG = (bf16_t*)(ws + B_OG), *Ob = (bf16_t*)(ws + B_O), *GA = (bf16_t*)(ws + B_GA), *GB = (bf16_t*)(ws + B_GB);
    bf16_t *Ub = (bf16_t*)(ws + WS_U), *POOLED = (bf16_t*)(ws + WS_POOLED), *PM = (bf16_t*)(ws + WS_PM), *Eb = (bf16_t*)(ws + B_E), *Pb = (bf16_t*)(ws + B_PB);
    const float* gains = a.in[I_GAINS];
    { volatile LAS unsigned* st0 = (volatile LAS unsigned*)(lds + 131072 + 256); if (tid < 2) st0[tid] = 0u; }
    __syncthreads();
    XcdBarrier xbar = xcd_barrier_post((unsigned*)(ws + WS_SS), (volatile LAS unsigned*)(lds + 131072 + 256));
    grid.sync();
#define GSYNC() xcd_barrier(xbar)
#define WT(off) ((bf16_t*)(ws + (off)))
    constexpr int NI_GU = 16 * 176, NI_D = 44 * 32, NI_IN = 16 * 208, NI_SQ = 16 * 32, NI_B = 8 * 32, NI_PP = 4 * 32;
    constexpr int NI_EARLY = NI_GU + NI_D + NI_IN, NITEMS = 2 * NI_GU + 2 * NI_D + NI_IN + 3 * NI_SQ + NI_B + NI_PP;
    constexpr int IT_D2 = NI_EARLY + NI_GU, IT_A = IT_D2 + NI_D, IT_PG = IT_A + 2 * NI_SQ, IT_B = IT_PG + NI_SQ, IT_PP = IT_B + NI_B;
#define CONVERT_ITEMS(lo_, hi_, gw_, ngw_) do { LAS float* scr_ = (LAS float*)(lds + wave * 16384); const int lane_ = otid() & 63; \
        for (int it = (lo_) + (gw_); it < (hi_); it += (ngw_)) { int r = it; const float* W; int K, N, kind = 0; bf16_t* dst; \
            if (r < NI_GU) { W = a.in[I_GU1]; K = 1024; N = 5632; dst = WT(W_GU1); kind = 1; } \
            else if ((r -= NI_GU) < NI_D) { W = a.in[I_D1]; K = 2816; N = 1024; dst = WT(W_D1); } \
            else if ((r -= NI_D) < NI_IN) { W = a.in[I_WIN]; K = 1024; N = 6656; dst = WT(W_IN); kind = 2; } \
            else if ((r -= NI_IN) < NI_GU) { W = a.in[I_GU2]; K = 1024; N = 5632; dst = WT(W_GU2); kind = 1; } \
            else if ((r -= NI_GU) < NI_D) { W = a.in[I_D2]; K = 2816; N = 1024; dst = WT(W_D2); } \
            else if ((r -= NI_D) < NI_SQ) { W = a.in[I_WA]; K = 1024; N = 1024; dst = WT(W_A); } \
            else if ((r -= NI_SQ) < NI_SQ) { W = a.in[I_WOUT]; K = 1024; N = 1024; dst = WT(W_OUT); } \
            else if ((r -= NI_SQ) < NI_SQ) { W = a.in[I_WPG]; K = 1024; N = 1024; dst = WT(W_PG); } \
            else if ((r -= NI_SQ) < NI_B) { W = a.in[I_WB]; K = 512; N = 1024; dst = WT(W_B); } \
            else { r -= NI_B; W = a.in[I_WPP]; K = 256; N = 1024; dst = WT(W_PP); } \
            const int nblk = N / 32, kb = r / nblk, nb = r % nblk, dn = nb * 32; \
            const int sn = kind == 1 ? map_gu(dn) : (kind == 2 ? map_in(dn) : dn); \
            transpose_item(W, N, sn, K, dst, dn, kb * 64, scr_, lane_); } } while (0)
#define SGW bx, G, wave, otid() & 63
#define GEMM(EpiT, E, Aptr, Btptr, N_, K_, nNp, pn0p, nNs, pn0s, rot) do { pg8::Gemm g_{(Aptr), (Btptr), M, (N_), (K_)}; TileSched S_; S_.init((nNp), (pn0p), (nNs), (pn0s), G, (bx + (rot)) % G); \
        pg8::gemm_phase<EpiT, TileSched, true, true>(lds, g_, S_, (E)); } while (0)

    {
        CONVERT_ITEMS(0, (G == 256) ? NI_GU : NI_EARLY, gw, NGW);
        const int gt = bx * NTHR + tid, NGT = G * NTHR;
        { const float* wp = a.in[I_WPOOL]; bf16_t* d = WT(W_POOL);
          for (int idx = gt; idx < 512 * 512 / 2; idx += NGT) { const int n = idx >> 8, k = (idx & 255) * 2, g1 = n >> 7, dd = n & 127, g2 = k >> 7, c = k & 127;
              float v0 = 0.f, v1 = 0.f; if (g1 == g2) { v0 = wp[(size_t)(g1 * 128 + c) * 128 + dd]; v1 = wp[(size_t)(g1 * 128 + c + 1) * 128 + dd]; }
              ((unsigned*)d)[idx] = pk2(v0, v1); } }
        for (int idx = gt; idx < 1024; idx += NGT) { const float l0 = a.in[I_LB][idx], l1 = a.in[I_LB][1024 + idx]; LB[idx] = 1.0f / (1.0f + __expf(l1 - l0)); }
        for (int m = gw; m < M; m += NGW) { const float* xr = (m < MP) ? a.in[I_XP] + (size_t)m * DM : a.in[I_XS] + (size_t)(m - MP) * DM; rms_row_to_bf16(xr, gains + 0 * DM, H + (size_t)m * DM, lane); }
    }
    GSYNC();
    { EpiSwiGLU E{ACT}; GEMM(EpiSwiGLU, E, H, WT(W_GU1), 5632, 1024, 22, 0, 22, 0, 0); }
    if (G == 256 && bx >= 150) {
        __syncthreads(); CONVERT_ITEMS(NI_GU, NI_EARLY, (bx - 150) * NWAVES + wave, 106 * NWAVES); }
    GSYNC();
    { EpiStore<false> E{Y, DM, nullptr}; GEMM(EpiStore<false>, E, ACT, WT(W_D1), 1024, DFF, 4, 0, 0, 0, 0); SStore ES{Y, DM, nullptr}; sgemm_sample(lds, ACT, WT(W_D1), 1024, DFF, ES, SGW);
    }
    GSYNC();
    row_phase<true>(Y, a.in[I_XP], a.in[I_XS], out + O_Y, H, gains + 1 * DM, 0.5f, gains + 2 * DM, gw, NGW, otid() & 63);
    GSYNC();
    { EpiIn E{ws, EG, LB}; GEMM(EpiIn, E, H, WT(W_IN), NIN, 1024, 14, 0, 26, 0, 0); }
    if (G == 256 && bx >= 154) {
        __syncthreads(); const int gw4 = (bx - 154) * NWAVES + wave;
        CONVERT_ITEMS(IT_A, IT_PG, gw4, 102 * NWAVES); CONVERT_ITEMS(IT_B, IT_PP, gw4, 102 * NWAVES);
        CONVERT_ITEMS(NI_EARLY, NI_EARLY + NI_GU, gw4, 102 * NWAVES); }
    GSYNC();
    hgrn_phase(lds, Qp, Kp, Vb, Ob, EG, a.in[I_SH], out + O_HP, out + O_HS, G, bx, otid());
    { const int half = (G >= 256) ? 128 : 0;
      if (bx >= half) { __syncthreads(); const int gw2 = (bx - half) * NWAVES + wave, ngw2 = (G - half) * NWAVES;
          if (G == 256) { CONVERT_ITEMS(IT_D2, IT_A, gw2, ngw2); CONVERT_ITEMS(IT_PG, IT_B, gw2, ngw2); CONVERT_ITEMS(IT_PP, NITEMS, gw2, ngw2); }
          else CONVERT_ITEMS(NI_EARLY, NITEMS, gw2, ngw2);
          prep_pool(Ub, POOLED, a.in[I_SP], out + O_PP, out + O_PS, gw2, ngw2, otid() & 63);
          asm volatile("s_waitcnt vmcnt(0)" ::: "memory"); __syncthreads();
          if (otid() == 0) { __builtin_amdgcn_fence(__ATOMIC_RELEASE, "agent"); asm volatile("s_waitcnt vmcnt(0)" ::: "memory");
              unsigned* cnt = (unsigned*)(ws + 14336); __hip_atomic_fetch_add(cnt, 1u, __ATOMIC_RELAXED, __HIP_MEMORY_SCOPE_AGENT);
              unsigned sp = 0; while (__hip_atomic_load(cnt, __ATOMIC_RELAXED, __HIP_MEMORY_SCOPE_AGENT) < (unsigned)(G - half)) { __builtin_amdgcn_s_sleep(2); if (++sp > (1u << 22)) break; }
              __builtin_amdgcn_fence(__ATOMIC_ACQUIRE, "agent"); asm volatile("s_waitcnt vmcnt(0)" ::: "memory"); }
          __syncthreads();
          { EpiStore<true> E{PM, BW, a.in[I_PSCALE]}; pg8::Gemm g_{POOLED, WT(W_POOL), M, 512, 512}; TileSched S_; S_.init(2, 0, 0, 0, G - half, bx - half);
            pg8::gemm_phase<EpiStore<true>, TileSched, true, true>(lds, g_, S_, E);
            SStore ES{PM, BW, a.in[I_PSCALE]}; sgemm_sample(lds, POOLED, WT(W_POOL), 512, 512, ES, bx - half, G - half, wave, otid() & 63); }
          __syncthreads();
          { EpiIn E{ws, EG, LB}; pg8::Gemm g_{H, WT(W_IN), M, NIN, 1024}; TileSched S_; S_.init(4, 14, 0, 0, G - half, bx - half);
            pg8::gemm_phase<EpiIn, TileSched, true, true>(lds, g_, S_, E); } } }
    GSYNC();
    if (bx & 1) prep_og(Ob, OG, a.in[I_GN], gw, NGW, otid() & 63);
    { EpiIn E{ws, EG, LB}; GEMM(EpiIn, E, H, WT(W_IN), NIN, 1024, 8, 18, 0, 0, 0); }
    if (!(bx & 1)) prep_og(Ob, OG, a.in[I_GN], gw, NGW, otid() & 63);
    GSYNC();
    {
        { EpiMulInPlace E{GA}; GEMM(EpiMulInPlace, E, OG, WT(W_A), 1024, 1024, 4, 0, 0, 0, 0); SMulInPlace ES{GA}; sgemm_sample(lds, OG, WT(W_A), 1024, 1024, ES, SGW); }
        { EpiFmaInPlace E{GA, GB}; GEMM(EpiFmaInPlace, E, PM, WT(W_B), 1024, 512, 4, 0, 0, 0, 0); SFmaInPlace ES{GA, GB}; sgemm_sample(lds, PM, WT(W_B), 1024, 512, ES, SGW); }
    }
    GSYNC();
    { EpiStore<false> E{Y, DM, nullptr};
      GEMM(EpiStore<false>, E, GB, WT(W_OUT), 1024, 1024, 4, 0, 0, 0, 0); { SStore ES{Y, DM, nullptr}; sgemm_sample(lds, GB, WT(W_OUT), 1024, 1024, ES, SGW); }
    }
    GSYNC();
    row_phase<true>(Y, out + O_Y, out + O_Y + (size_t)MP * DM, out + O_Y, H, gains + 3 * DM, 1.0f, gains + 4 * DM, gw, NGW, otid() & 63);
    GSYNC();
    { EpiSwiGLU E{ACT}; GEMM(EpiSwiGLU, E, H, WT(W_GU2), 5632, 1024, 22, 0, 22, 0, 0); }
    { const int first = (G == 256) ? 150 : 0;
      if (bx >= first) { const int gt = (bx - first) * NTHR + otid(), NGT = (G - first) * NTHR;
        for (int idx = gt; idx < M * PLE / 4; idx += NGT) { const int e = idx * 4; const float* src = (e < MP * PLE) ? a.in[I_PP] + e : a.in[I_PS] + (e - MP * PLE); const f32x4 v = *(const f32x4*)src;
            u32x2 w; w.x = pk2(v.x, v.y); w.y = pk2(v.z, v.w); ((u32x2*)Pb)[idx] = w; } } }
    GSYNC();
    { EpiStore<false> E{Y, DM, nullptr}; GEMM(EpiStore<false>, E, ACT, WT(W_D2), 1024, DFF, 4, 0, 0, 0, 0); SStore ES{Y, DM, nullptr}; sgemm_sample(lds, ACT, WT(W_D2), 1024, DFF, ES, SGW); }
    GSYNC();
    row_phase<true>(Y, out + O_Y, out + O_Y + (size_t)MP * DM, out + O_Y, H, gains + 5 * DM, 0.5f, gains + 6 * DM, gw, NGW, otid() & 63);
    GSYNC();
    { EpiStore<false> E{Eb, DM, nullptr}; GEMM(EpiStore<false>, E, Pb, WT(W_PP), 1024, PLE, 4, 0, 0, 0, 0); SStore ES{Eb, DM, nullptr}; sgemm_sample(lds, Pb, WT(W_PP), 1024, PLE, ES, SGW); }
    { EpiPleGate E{Eb, Y}; GEMM(EpiPleGate, E, H, WT(W_PG), 1024, 1024, 4, 0, 0, 0, 0); SPleGate ES{Eb, Y}; sgemm_sample(lds, H, WT(W_PG), 1024, 1024, ES, SGW); }
    GSYNC();
    row_phase<false>(Y, out + O_Y, out + O_Y + (size_t)MP * DM, out + O_Y, nullptr, gains + 7 * DM, 1.0f, nullptr, gw, NGW, otid() & 63);
#undef WT
#undef GEMM
}

extern "C" void kernel_launch(void* const* d_in, const int* in_sizes, int n_in, void* d_out, int out_size, void* d_ws, size_t ws_size, hipStream_t stream) {
    static int grid = 0;
    if (grid == 0) {
        if (n_in != 21 || in_sizes[0] != MP * DM || ws_size < WS_NEED) { fprintf(stderr, "kernel_launch: unexpected shapes (n_in %d, ws %zu, need %zu)\n", n_in, ws_size, (size_t)WS_NEED); grid = -1; return; }
        int dev = 0, cus = 0, per_cu = 0;
        hipGetDevice(&dev); hipDeviceGetAttribute(&cus, hipDeviceAttributeMultiprocessorCount, dev);
        hipFuncSetAttribute((const void*)mega_fwd, hipFuncAttributeMaxDynamicSharedMemorySize, LDS_BYTES);
        hipOccupancyMaxActiveBlocksPerMultiprocessor(&per_cu, (const void*)mega_fwd, NTHR, LDS_BYTES);
        if (per_cu < 1) { fprintf(stderr, "kernel_launch: occupancy query says %d blocks/CU\n", per_cu); per_cu = 1; }
        grid = cus;
        if (grid > 256) grid = 256;
        grid &= ~7;
    }
    if (grid <= 0) return;
    Args a{};
    for (int i = 0; i < 21; ++i) a.in[i] = (const float*)d_in[i];
    a.out = (float*)d_out; a.ws = (unsigned char*)d_ws;
    if (hipMemsetAsync(d_ws, 0, 16384, stream) != hipSuccess) { fprintf(stderr, "kernel_launch: memset failed\n"); return; }
    void* args[] = {&a};
    hipError_t e = hipLaunchCooperativeKernel((const void*)mega_fwd, dim3(grid), dim3(NTHR), args, LDS_BYTES, stream);
    if (e != hipSuccess) fprintf(stderr, "kernel_launch: cooperative launch failed: %s (grid %d)\n", hipGetErrorString(e), grid);
}
```

```cpp
#include <hip/hip_runtime.h>
#include <hip/hip_cooperative_groups.h>
#include <cstdio>
#include <cstdint>
namespace cg = cooperative_groups;
namespace pg8 {
#define PG8_LAS __attribute__((address_space(3)))
typedef unsigned short bf16_t;
typedef short bf16x8 __attribute__((ext_vector_type(8)));
typedef float f32x4 __attribute__((ext_vector_type(4)));
typedef unsigned u32x4 __attribute__((ext_vector_type(4)));
constexpr int BM = 256, BK = 64, HALF = 128, HTB = HALF * BK * 2  , STAGE_BYTES = 8 * HTB, NXCD = 8, WGM = 8;

__host__ __device__ __forceinline__ int lds_byte(int r, int c) { const int st = (r >> 4) * 2 + (c >> 5), rr = r & 15, cc = c & 31, ob = rr * 64 + cc * 2; return st * 1024 + (ob ^ (((ob >> 9) & 1) << 5)); }
__host__ __device__ __forceinline__ void stage_rc(int b, int& R, int& C) { const int st = b / 1024, sb = b % 1024, swz = sb ^ (((sb >> 9) & 1) << 5); R = (st >> 1) * 16 + swz / 64; C = (st & 1) * 32 + (swz % 64) / 2; }
__host__ __device__ __forceinline__ int perm32(int rho) { const int n = rho >> 4, i = rho & 15; return 8 * (i >> 2) + 4 * n + (i & 3); }

struct Unit { int pm, pn; };
struct Gemm { const bf16_t* A; const bf16_t* Bt; int M, N, K; };

struct StaticOrder {
    int nM, nN, nwg, G, c;
    __host__ __device__ void init(int M, int N, int G_, int c_) { nM = M / BM; nN = N / BM; nwg = nM * nN; G = G_; c = c_; }
    __host__ __device__ bool next(int i, Unit& u) const {
        const long L = (long)i * G + c; if (L >= nwg) return false;
        int wgid = (int)L; { const int q = nwg / NXCD, r = nwg % NXCD, xcd = wgid % NXCD, off = wgid / NXCD; wgid = (xcd < r ? xcd * (q + 1) : r * (q + 1) + (xcd - r) * q) + off; }
        const int nig = WGM * nN, gid = wgid / nig, fm = gid * WGM, gsz = (nM - fm) < WGM ? (nM - fm) : WGM;
        u.pm = fm + ((wgid % nig) % gsz); u.pn = (wgid % nig) / gsz; return true;
    }
    __device__ __forceinline__ void a_ready(const Unit&) const {}
    __device__ __forceinline__ void done(const Unit&) const {}
};

__device__ __forceinline__ unsigned cvt_pk_bf16(float lo, float hi) { unsigned r; asm volatile("v_cvt_pk_bf16_f32 %0, %1, %2" : "=v"(r) : "v"(lo), "v"(hi)); return r; }
typedef float f32x2 __attribute__((ext_vector_type(2)));
template <class Epi, class Sched, bool ALIGN_EPI = false, bool SP2 = false>
__device__ __forceinline__ void gemm_phase(PG8_LAS unsigned char* lds, const Gemm g, const Sched& S, const Epi& E) {
    int tid_ = threadIdx.x; asm volatile("" : "+v"(tid_));
    const int tid = tid_, wid = __builtin_amdgcn_readfirstlane(tid >> 6), lane = tid & 63, wr = wid >> 2, wc = wid & 3, fr = lane & 15, fq = lane >> 4;
    const int K = g.K, nt = K / BK;
    unsigned voffA[2], voffB[2];
#pragma unroll
    for (int i = 0; i < 2; ++i) { int R, C; stage_rc(tid * 16 + i * 8192, R, C); const int Rb = Epi::PERM ? ((R & ~31) + perm32(R & 31)) : R;
        voffA[i] = (unsigned)(R * K + C) * 2u; voffB[i] = (unsigned)(Rb * K + C) * 2u; }
    const size_t kstep = (size_t)(BK * 2);
    const size_t hstep = (size_t)HALF * K * 2;
    const size_t tstep = 2 * hstep;
    const unsigned ldsw = (unsigned)wid * 1024u;
    const int aoff = lds_byte(wr * 64 + fr, fq * 8), boff = lds_byte(wc * 32 + fr, fq * 8);
#define PG8_SA(b, h) (((b) * 2 + (h)) * HTB)
#define PG8_SB(b, h) ((4 + (b) * 2 + (h)) * HTB)
#define PG8_STAGE(bufoff, gbase, voff) do { _Pragma("unroll") for (int _i = 0; _i < 2; ++_i) \
        __builtin_amdgcn_global_load_lds((const unsigned*)((const char*)(gbase) + (voff)[_i]), (PG8_LAS unsigned*)(lds + (bufoff) + ldsw + _i * 8192), 16, 0, 0); } while (0)
#define PG8_LDA(dst, b, h) do { _Pragma("unroll") for (int m = 0; m < 4; ++m) _Pragma("unroll") for (int k = 0; k < 2; ++k) dst[m][k] = *(const PG8_LAS bf16x8*)(lds + PG8_SA(b, h) + aoff + m * 2048 + k * 1024); } while (0)
#define PG8_LDB(dst, b, h) do { _Pragma("unroll") for (int n = 0; n < 2; ++n) _Pragma("unroll") for (int k = 0; k < 2; ++k) dst[n][k] = *(const PG8_LAS bf16x8*)(lds + PG8_SB(b, h) + boff + n * 2048 + k * 1024); } while (0)
#define PG8_MMA(ai, bj, At, Bt) do { __builtin_amdgcn_s_setprio(1); _Pragma("unroll") for (int m = 0; m < 4; ++m) _Pragma("unroll") for (int n = 0; n < 2; ++n) _Pragma("unroll") for (int k = 0; k < 2; ++k) \
        acc[ai][bj][m][n] = __builtin_amdgcn_mfma_f32_16x16x32_bf16(Bt[n][k], At[m][k], acc[ai][bj][m][n], 0, 0, 0); __builtin_amdgcn_s_setprio(0); } while (0)
#define PG8_WAIT_V(n) asm volatile("s_waitcnt vmcnt(" #n ")" ::: "memory")
#define PG8_WAIT_L(n) asm volatile("s_waitcnt lgkmcnt(" #n ")" ::: "memory")
#define PG8_BAR __builtin_amdgcn_s_barrier()
#define PG8_SCHED __builtin_amdgcn_sched_barrier(0)
    Unit cur, nxt; int ui = 0;
    if (!S.next(0, cur)) return;
    f32x4 acc[2][2][4][2];
#pragma unroll
    for (int a = 0; a < 2; ++a)
#pragma unroll
        for (int b = 0; b < 2; ++b)
#pragma unroll
            for (int m = 0; m < 4; ++m)
#pragma unroll
                for (int n = 0; n < 2; ++n) acc[a][b][m][n] = (f32x4){0.f, 0.f, 0.f, 0.f};
    bf16x8 At[4][2], B0[2][2], B1[2][2];
    const char* cA = (const char*)g.A + (size_t)cur.pm * tstep; const char* cB = (const char*)g.Bt + (size_t)cur.pn * tstep;
    S.a_ready(cur);
    if constexpr (SP2) {
        PG8_STAGE(PG8_SB(0, 0), cB, voffB); PG8_STAGE(PG8_SB(0, 1), cB + hstep, voffB); PG8_STAGE(PG8_SA(0, 0), cA, voffA); PG8_STAGE(PG8_SA(0, 1), cA + hstep, voffA);
        if (wr == 1) PG8_BAR;
        PG8_WAIT_V(2); PG8_BAR;
        PG8_STAGE(PG8_SB(1, 0), cB + kstep, voffB); PG8_STAGE(PG8_SA(1, 0), cA + kstep, voffA); PG8_STAGE(PG8_SB(1, 1), cB + hstep + kstep, voffB);
        PG8_WAIT_V(6); PG8_BAR;
    } else {
        PG8_STAGE(PG8_SB(0, 0), cB, voffB); PG8_STAGE(PG8_SA(0, 0), cA, voffA); PG8_STAGE(PG8_SB(0, 1), cB + hstep, voffB); PG8_STAGE(PG8_SA(0, 1), cA + hstep, voffA);
        if (wr == 1) PG8_BAR;
        PG8_WAIT_V(4); PG8_BAR;
        PG8_STAGE(PG8_SB(1, 0), cB + kstep, voffB); PG8_STAGE(PG8_SA(1, 0), cA + kstep, voffA); PG8_STAGE(PG8_SB(1, 1), cB + hstep + kstep, voffB);
        PG8_WAIT_V(6); PG8_BAR;
    }
    for (;;) {
        const bool has_next = S.next(ui + 1, nxt);
        const char* nA = has_next ? (const char*)g.A + (size_t)nxt.pm * tstep : cA; const char* nB = has_next ? (const char*)g.Bt + (size_t)nxt.pn * tstep : cB;
        for (int t = 0; t < nt; t += 2) {
            const bool last = (t == nt - 2);
            const char* a1 = cA + (size_t)(t + 1) * kstep;
            const char* a2 = last ? nA : cA + (size_t)(t + 2) * kstep; const char* b2 = last ? nB : cB + (size_t)(t + 2) * kstep;
            const char* a3 = a2 + kstep; const char* b3 = b2 + kstep;
            if (last && has_next) S.a_ready(nxt);
            if constexpr (SP2) {
            PG8_LDB(B0, 0, 0); PG8_LDB(B1, 0, 1); PG8_SCHED; PG8_LDA(At, 0, 0); PG8_STAGE(PG8_SA(1, 1), a1 + hstep, voffA);
            PG8_WAIT_V(8); PG8_WAIT_L(0); PG8_BAR; PG8_MMA(0, 0, At, B0); PG8_MMA(0, 1, At, B1); PG8_BAR; PG8_SCHED;
            PG8_LDA(At, 0, 1); PG8_STAGE(PG8_SB(0, 0), b2, voffB); PG8_STAGE(PG8_SB(0, 1), b2 + hstep, voffB); PG8_STAGE(PG8_SA(0, 0), a2, voffA);
            PG8_WAIT_V(8); PG8_WAIT_L(0); PG8_BAR; PG8_MMA(1, 0, At, B0); PG8_MMA(1, 1, At, B1); PG8_BAR; PG8_SCHED;
            PG8_LDB(B0, 1, 0); PG8_LDB(B1, 1, 1); PG8_SCHED; PG8_LDA(At, 1, 0); PG8_STAGE(PG8_SA(0, 1), a2 + hstep, voffA);
            PG8_WAIT_V(8); PG8_WAIT_L(0); PG8_BAR; PG8_MMA(0, 0, At, B0); PG8_MMA(0, 1, At, B1); PG8_BAR; PG8_SCHED;
            PG8_LDA(At, 1, 1); PG8_STAGE(PG8_SB(1, 0), b3, voffB); PG8_STAGE(PG8_SB(1, 1), b3 + hstep, voffB); PG8_STAGE(PG8_SA(1, 0), a3, voffA);
            PG8_WAIT_V(8); PG8_WAIT_L(0); PG8_BAR; PG8_MMA(1, 0, At, B0); PG8_MMA(1, 1, At, B1); PG8_BAR; PG8_SCHED;
            } else {
            PG8_LDB(B0, 0, 0); PG8_SCHED; PG8_LDA(At, 0, 0); PG8_STAGE(PG8_SA(1, 1), a1 + hstep, voffA);
            PG8_WAIT_L(8); PG8_BAR; PG8_WAIT_L(0); PG8_MMA(0, 0, At, B0); PG8_BAR; PG8_SCHED;
            PG8_LDB(B1, 0, 1); PG8_STAGE(PG8_SB(0, 0), b2, voffB);
            PG8_BAR; PG8_WAIT_L(0); PG8_MMA(0, 1, At, B1); PG8_BAR;
            PG8_LDA(At, 0, 1); PG8_STAGE(PG8_SA(0, 0), a2, voffA);
            PG8_BAR; PG8_WAIT_L(0); PG8_MMA(1, 0, At, B0); PG8_BAR; PG8_SCHED;
            PG8_STAGE(PG8_SB(0, 1), b2 + hstep, voffB);
            PG8_WAIT_V(6); PG8_BAR; PG8_MMA(1, 1, At, B1); PG8_BAR;
            PG8_LDB(B0, 1, 0); PG8_SCHED; PG8_LDA(At, 1, 0); PG8_STAGE(PG8_SA(0, 1), a2 + hstep, voffA);
            PG8_WAIT_L(8); PG8_BAR; PG8_WAIT_L(0); PG8_MMA(0, 0, At, B0); PG8_BAR; PG8_SCHED;
            PG8_LDB(B1, 1, 1); PG8_STAGE(PG8_SB(1, 0), b3, voffB);
            PG8_BAR; PG8_WAIT_L(0); PG8_MMA(0, 1, At, B1); PG8_BAR;
            PG8_LDA(At, 1, 1); PG8_STAGE(PG8_SA(1, 0), a3, voffA);
            PG8_BAR; PG8_WAIT_L(0); PG8_MMA(1, 0, At, B0); PG8_BAR; PG8_SCHED;
            PG8_STAGE(PG8_SB(1, 1), b3 + hstep, voffB);
            PG8_WAIT_V(6); PG8_BAR; PG8_MMA(1, 1, At, B1); PG8_BAR;
            }
        }
        if constexpr (ALIGN_EPI) { if (wr == 0) PG8_BAR; }
        if constexpr (!Epi::AFTER_DRAIN) { E(acc, cur, wr, wc, fr, fq); S.done(cur); }
        if (!has_next) break;
#pragma unroll
        for (int a = 0; a < 2; ++a)
#pragma unroll
            for (int b = 0; b < 2; ++b)
#pragma unroll
                for (int m = 0; m < 4; ++m)
#pragma unroll
                    for (int n = 0; n < 2; ++n) acc[a][b][m][n] = (f32x4){0.f, 0.f, 0.f, 0.f};
        cur = nxt; cA = nA; cB = nB; ++ui;
        if constexpr (ALIGN_EPI) { if (wr == 1) PG8_BAR; }
    }
    PG8_WAIT_V(0);
    if constexpr (!ALIGN_EPI) { if (wr == 0) PG8_BAR; }
    PG8_BAR;
    if constexpr (Epi::AFTER_DRAIN) { E.fused(acc, cur, wr, wc, fr, fq, lds, wid, lane); S.done(cur); }
#undef PG8_SA
#undef PG8_SB
#undef PG8_STAGE
#undef PG8_LDA
#undef PG8_LDB
#undef PG8_MMA
#undef PG8_WAIT_V
#undef PG8_WAIT_L
#undef PG8_BAR
#undef PG8_SCHED
}
}

#define LAS __attribute__((address_space(3)))
using pg8::bf16_t; using pg8::bf16x8; using pg8::f32x4; using pg8::u32x4; using pg8::Unit;
typedef float f32x2_t __attribute__((ext_vector_type(2))); typedef __bf16 bf16x2_t __attribute__((ext_vector_type(2)));
__device__ __forceinline__ unsigned cvt_pk_bf16(float lo, float hi) { f32x2_t v = {lo, hi}; bf16x2_t b = __builtin_convertvector(v, bf16x2_t); return __builtin_bit_cast(unsigned, b); }
typedef unsigned u32x2 __attribute__((ext_vector_type(2)));
typedef short s16x4 __attribute__((ext_vector_type(4)));
constexpr int DM = 1024, MP = 16384, MS = 256, M = MP + MS, DFF = 2816, NIN = 6656, BW = 512, PLE = 256;
constexpr int SEQ = 8192, DSEQ = 32, PAST = 2048, NB_P = 2, NB_S = 8;
constexpr float EPS = 1e-6f;
constexpr int NWAVES = 8, NTHR = 512;
constexpr int LDS_BYTES = 147456;

constexpr size_t MiB = 1u << 20;
constexpr size_t U1 = (size_t)M * 1024 * 2;
constexpr size_t WS_SS = 0, WS_LB = 1 * MiB, WS_EG = 2 * MiB, WS_W = 4 * MiB;
constexpr size_t W_GU1 = WS_W, W_D1 = W_GU1 + (size_t)5632 * 1024 * 2, W_IN = W_D1 + (size_t)1024 * 2816 * 2, W_A = W_IN + (size_t)6656 * 1024 * 2,
                 W_POOL = W_A + (size_t)1024 * 1024 * 2, W_B = W_POOL + (size_t)512 * 512 * 2, W_OUT = W_B + (size_t)1024 * 512 * 2, W_GU2 = W_OUT + (size_t)1024 * 1024 * 2,
                 W_D2 = W_GU2 + (size_t)5632 * 1024 * 2, W_PP = W_D2 + (size_t)1024 * 2816 * 2, W_PG = W_PP + (size_t)1024 * 256 * 2, W_END = W_PG + (size_t)1024 * 1024 * 2;
constexpr size_t WS_H = 59 * MiB, WS_Y = WS_H + U1, WS_BIG = WS_Y + U1;
constexpr size_t B_QP = WS_BIG, B_KP = WS_BIG + 33 * MiB, B_VB = WS_BIG + 66 * MiB, B_O = B_VB  , B_OG = WS_BIG + 99 * MiB, B_GA = B_QP + MiB / 2, B_GB = B_KP + MiB / 2;
constexpr size_t B_ACT = WS_BIG, B_E = WS_BIG, B_PB = W_GU1  ;
constexpr size_t WS_U = WS_Y, WS_POOLED = WS_Y + (size_t)M * 512 * 2, WS_PM = W_GU1  ;
constexpr size_t WS_NEED = B_OG + U1;
static_assert(W_END <= WS_H && WS_NEED <= 256 * MiB && (size_t)M * DFF * 2 <= 131 * MiB && U1 <= 33 * MiB - MiB / 2, "d_ws map");
constexpr size_t O_Y = 0, O_HP = (size_t)M * DM, O_PP = O_HP + (size_t)NB_P * 8 * 128 * 128, O_HS = O_PP + (size_t)NB_P * 15 * 512, O_PS = O_HS + (size_t)NB_S * 8 * 128 * 128;

__device__ __forceinline__ float bf2f(unsigned short v) { return __uint_as_float((unsigned)v << 16); }
__device__ __forceinline__ float bflo(unsigned w) { return __uint_as_float(w << 16); }
__device__ __forceinline__ float bfhi(unsigned w) { return __uint_as_float(w & 0xffff0000u); }
__device__ __forceinline__ f32x4 zero_acc() { f32x4 z = (f32x4){0.f, 0.f, 0.f, 0.f}; asm volatile("" : "+v"(z)); return z; }
__device__ __forceinline__ int otid() { int t = threadIdx.x; asm volatile("" : "+v"(t)); return t; }
__device__ __forceinline__ float fexp(float x) { return __builtin_amdgcn_exp2f(x * 1.44269504f); }
__device__ __forceinline__ float flog(float x) { return __builtin_amdgcn_logf(x) * 0.69314718f; }
__device__ __forceinline__ float frcp(float x) { return __builtin_amdgcn_rcpf(x); }
__device__ __forceinline__ float sigm(float x) { return frcp(1.0f + fexp(-x)); }
__device__ __forceinline__ float wave_sum(float v) {
#pragma unroll
    for (int o = 1; o < 64; o <<= 1) v += __shfl_xor(v, o);
    return v;
}
template <int CTRL> __device__ __forceinline__ float dppm(float x) { return __int_as_float(__builtin_amdgcn_update_dpp(0x3f800000, __float_as_int(x), CTRL, 0xf, 0xf, false)); }
template <int CTRL> __device__ __forceinline__ float dppf(float x) { return __int_as_float(__builtin_amdgcn_update_dpp(0, __float_as_int(x), CTRL, 0xf, 0xf, true)); }

struct TileSched {
    int nNp, pn0p, nNs, pn0s, nwgP, G, c;
    __device__ __forceinline__ void init(int nNp_, int pn0p_, int nNs_, int pn0s_, int G_, int c_) { nNp = nNp_; pn0p = pn0p_; nNs = nNs_; pn0s = pn0s_; nwgP = 64 * nNp_; G = G_; c = c_; }
    __device__ __forceinline__ bool next(int i, Unit& u) const {
        long L = (long)i * G + c;
        if (L < nwgP) {
            int wgid = (int)L; { const int q = nwgP / 8, xcd = wgid % 8, off = wgid / 8; wgid = xcd * q + off; }
            const int nig = 8 * nNp, gid = wgid / nig, fm = gid * 8;
            u.pm = fm + ((wgid % nig) % 8); u.pn = pn0p + (wgid % nig) / 8; return true;
        }
        L -= nwgP;
        if (L < nNs) { u.pm = 64; u.pn = pn0s + (int)L; return true; }
        return false;
    }
    __device__ __forceinline__ void a_ready(const Unit&) const {}
    __device__ __forceinline__ void done(const Unit&) const {}
};

#define EPI_ROWS(ai, m) (u.pm * 256 + (ai) * 128 + wr * 64 + (m) * 16 + fr)
__device__ __forceinline__ u32x4 pack8(const f32x4& a, const f32x4& b) { u32x4 w; w.x = cvt_pk_bf16(a[0], a[1]); w.y = cvt_pk_bf16(a[2], a[3]); w.z = cvt_pk_bf16(b[0], b[1]); w.w = cvt_pk_bf16(b[2], b[3]); return w; }
__device__ __forceinline__ void unpack8(const u32x4& w, f32x4& a, f32x4& b) { a = (f32x4){bflo(w.x), bfhi(w.x), bflo(w.y), bfhi(w.y)}; b = (f32x4){bflo(w.z), bfhi(w.z), bflo(w.w), bfhi(w.w)}; }

struct EpiSwiGLU {
    static constexpr bool PERM = true, AFTER_DRAIN = false;
    bf16_t* O;
    __device__ __forceinline__ void operator()(f32x4 (&acc)[2][2][4][2], const Unit& u, int wr, int wc, int fr, int fq) const {
        const int col0 = u.pn * 128 + wc * 32 + 8 * fq;
#pragma unroll
        for (int ai = 0; ai < 2; ++ai)
#pragma unroll
            for (int m = 0; m < 4; ++m) {
                f32x4 o[2];
#pragma unroll
                for (int n = 0; n < 2; ++n)
#pragma unroll
                    for (int j = 0; j < 4; ++j) { const float a = acc[ai][0][m][n][j], b = acc[ai][1][m][n][j]; o[n][j] = a * sigm(a) * b; }
                *(u32x4*)(O + (size_t)EPI_ROWS(ai, m) * DFF + col0) = pack8(o[0], o[1]);
            }
    }
};
template <bool SCALE> struct EpiStore {
    static constexpr bool PERM = true, AFTER_DRAIN = false;
    bf16_t* O; int ldc; const float* scale;
    __device__ __forceinline__ void operator()(f32x4 (&acc)[2][2][4][2], const Unit& u, int wr, int wc, int fr, int fq) const {
#pragma unroll
        for (int bj = 0; bj < 2; ++bj) {
            const int col0 = u.pn * 256 + bj * 128 + wc * 32 + 8 * fq;
            f32x4 s0 = (f32x4){1.f, 1.f, 1.f, 1.f}, s1 = s0;
            if (SCALE) { s0 = *(const f32x4*)(scale + col0); s1 = *(const f32x4*)(scale + col0 + 4); }
#pragma unroll
            for (int ai = 0; ai < 2; ++ai)
#pragma unroll
                for (int m = 0; m < 4; ++m) *(u32x4*)(O + (size_t)EPI_ROWS(ai, m) * ldc + col0) = pack8(acc[ai][bj][m][0] * s0, acc[ai][bj][m][1] * s1);
        }
    }
};
struct EpiMulInPlace {
    static constexpr bool PERM = true, AFTER_DRAIN = false;
    bf16_t* Gt;
    __device__ __forceinline__ void operator()(f32x4 (&acc)[2][2][4][2], const Unit& u, int wr, int wc, int fr, int fq) const {
#pragma unroll
        for (int bj = 0; bj < 2; ++bj) {
            const int col0 = u.pn * 256 + bj * 128 + wc * 32 + 8 * fq;
#pragma unroll
            for (int ai = 0; ai < 2; ++ai)
#pragma unroll
                for (int m = 0; m < 4; ++m) { bf16_t* p = Gt + (size_t)EPI_ROWS(ai, m) * DM + col0; f32x4 g0, g1; unpack8(*(const u32x4*)p, g0, g1);
                    *(u32x4*)p = pack8(g0 * acc[ai][bj][m][0], g1 * acc[ai][bj][m][1]); }
        }
    }
};
struct EpiFmaInPlace {
    static constexpr bool PERM = true, AFTER_DRAIN = false;
    const bf16_t* T1; bf16_t* Gb;
    __device__ __forceinline__ void operator()(f32x4 (&acc)[2][2][4][2], const Unit& u, int wr, int wc, int fr, int fq) const {
#pragma unroll
        for (int bj = 0; bj < 2; ++bj) {
            const int col0 = u.pn * 256 + bj * 128 + wc * 32 + 8 * fq;
#pragma unroll
            for (int ai = 0; ai < 2; ++ai)
#pragma unroll
                for (int m = 0; m < 4; ++m) { const size_t off = (size_t)EPI_ROWS(ai, m) * DM + col0; f32x4 g0, g1, t0, t1; unpack8(*(const u32x4*)(Gb + off), g0, g1); unpack8(*(const u32x4*)(T1 + off), t0, t1);
                    *(u32x4*)(Gb + off) = pack8(t0 + g0 * acc[ai][bj][m][0], t1 + g1 * acc[ai][bj][m][1]); }
        }
    }
};
struct EpiPleGate {
    static constexpr bool PERM = true, AFTER_DRAIN = false;
    const bf16_t* E; bf16_t* O;
    __device__ __forceinline__ void operator()(f32x4 (&acc)[2][2][4][2], const Unit& u, int wr, int wc, int fr, int fq) const {
#pragma unroll
        for (int bj = 0; bj < 2; ++bj) {
            const int col0 = u.pn * 256 + bj * 128 + wc * 32 + 8 * fq;
#pragma unroll
            for (int ai = 0; ai < 2; ++ai)
#pragma unroll
                for (int m = 0; m < 4; ++m) { const size_t off = (size_t)EPI_ROWS(ai, m) * DM + col0; f32x4 e0, e1; unpack8(*(const u32x4*)(E + off), e0, e1); f32x4 o0, o1;
#pragma unroll
                    for (int j = 0; j < 4; ++j) { o0[j] = sigm(acc[ai][bj][m][0][j]) * e0[j]; o1[j] = sigm(acc[ai][bj][m][1][j]) * e1[j]; }
                    *(u32x4*)(O + off) = pack8(o0, o1); }
        }
    }
};
struct EpiIn {
    static constexpr bool PERM = true, AFTER_DRAIN = false;
    unsigned char* ws; float* EG; const float* lb;
    __device__ __forceinline__ void operator()(f32x4 (&acc)[2][2][4][2], const Unit& u, int wr, int wc, int fr, int fq) const {
        const int cin = wc * 32 + 8 * fq;
        bf16_t* Qp = (bf16_t*)(ws + B_QP); bf16_t* Kp = (bf16_t*)(ws + B_KP);
        if (u.pn < 8) {
            const int h = u.pn; const bool smp = (u.pm == 64);
            const f32x4 lb0 = *(const f32x4*)(lb + h * 128 + cin), lb1 = *(const f32x4*)(lb + h * 128 + cin + 4);
#pragma unroll
            for (int ai = 0; ai < 2; ++ai) {
                f32x4 egA[2], egB[2];
#pragma unroll
                for (int n = 0; n < 2; ++n)
#pragma unroll
                    for (int j = 0; j < 4; ++j) {
                        const float lbv = n ? lb1[j] : lb0[j], omlb = 1.0f - lbv;
                        float inc[4], tot[4], kk[4];
#pragma unroll
                        for (int m = 0; m < 4; ++m) {
                            float fz = acc[ai][1][m][n][j]; fz = fminf(fmaxf(fz, -30.f), 30.f);
                            const float e = fexp(-fz), sg = frcp(1.0f + e);
                            kk[m] = omlb * e * sg;
                            float x = lbv + omlb * sg;
                            x *= dppm<0x111>(x); x *= dppm<0x112>(x); x *= dppm<0x114>(x); x *= dppm<0x118>(x);
                            inc[m] = x; tot[m] = dppf<0x15F>(x);
                        }
                        const float off1 = tot[0], off2 = smp ? 1.f : tot[0] * tot[1], off3 = off2 * tot[2];
                        const float lastA = smp ? tot[0] * tot[1] : off3 * tot[3], lastB = tot[2] * tot[3];
                        const float g[4] = {inc[0], inc[1] * off1, inc[2] * off2, inc[3] * off3};
#pragma unroll
                        for (int m = 0; m < 4; ++m) {
                            const float q = acc[ai][0][m][n][j];
                            const float eg_ = g[m], d_ = 1.0f + fexp(-fmaxf(q, -30.f)), r_ = frcp(d_ * eg_);
                            acc[ai][0][m][n][j] = (q * eg_) * (eg_ * r_);
                            acc[ai][1][m][n][j] = kk[m] * (d_ * r_);
                        }
                        egA[n][j] = lastA; egB[n][j] = lastB;
                    }
#pragma unroll
                for (int m = 0; m < 4; ++m) { const size_t off = (size_t)EPI_ROWS(ai, m) * DM + h * 128 + cin;
                    *(u32x4*)(Qp + off) = pack8(acc[ai][0][m][0], acc[ai][0][m][1]); *(u32x4*)(Kp + off) = pack8(acc[ai][1][m][0], acc[ai][1][m][1]); }
                if (fr == 0) {
                    if (!smp) { float* p = EG + (size_t)(u.pm * 4 + ai * 2 + wr) * 1024 + h * 128 + cin; *(f32x4*)p = egA[0]; *(f32x4*)(p + 4) = egA[1]; }
                    else { float* p = EG + (size_t)(256 + ai * 4 + wr * 2) * 1024 + h * 128 + cin; *(f32x4*)p = egA[0]; *(f32x4*)(p + 4) = egA[1]; *(f32x4*)(p + 1024) = egB[0]; *(f32x4*)(p + 1028) = egB[1]; }
                }
            }
            return;
        }
        size_t boff; int ldc, c0, act;
        if (u.pn < 12) { boff = B_VB; ldc = 1024; c0 = (u.pn - 8) * 256; act = 0; }
        else if (u.pn < 14) { boff = WS_U; ldc = 512; c0 = (u.pn - 12) * 256; act = 0; }
        else if (u.pn < 18) { boff = B_OG; ldc = 1024; c0 = (u.pn - 14) * 256; act = 1; }
        else if (u.pn < 22) { boff = B_GA; ldc = 1024; c0 = (u.pn - 18) * 256; act = 2; }
        else { boff = B_GB; ldc = 1024; c0 = (u.pn - 22) * 256; act = 2; }
        bf16_t* O = (bf16_t*)(ws + boff);
#pragma unroll
        for (int bj = 0; bj < 2; ++bj)
#pragma unroll
            for (int ai = 0; ai < 2; ++ai)
#pragma unroll
                for (int m = 0; m < 4; ++m) {
                    f32x4 o[2];
#pragma unroll
                    for (int n = 0; n < 2; ++n)
#pragma unroll
                        for (int j = 0; j < 4; ++j) { const float x = acc[ai][bj][m][n][j]; const float s = sigm(x); o[n][j] = act == 0 ? x : (act == 1 ? x * s : s); }
                    *(u32x4*)(O + (size_t)EPI_ROWS(ai, m) * ldc + c0 + bj * 128 + cin) = pack8(o[0], o[1]);
                }
    }
};

__device__ __forceinline__ u32x2 pack4(const f32x4& a) { u32x2 w; w.x = cvt_pk_bf16(a[0], a[1]); w.y = cvt_pk_bf16(a[2], a[3]); return w; }
__device__ __forceinline__ f32x4 unpack4(const u32x2& w) { return (f32x4){bflo(w.x), bfhi(w.x), bflo(w.y), bfhi(w.y)}; }
struct SStore { bf16_t* O; int ldc; const float* scale;
    __device__ __forceinline__ void operator()(int row, int col, f32x4 v) const { if (scale) v = v * *(const f32x4*)(scale + col); *(u32x2*)(O + (size_t)row * ldc + col) = pack4(v); } };
struct SMulInPlace { bf16_t* Gt;
    __device__ __forceinline__ void operator()(int row, int col, f32x4 v) const { bf16_t* p = Gt + (size_t)row * DM + col; *(u32x2*)p = pack4(unpack4(*(const u32x2*)p) * v); } };
struct SFmaInPlace { const bf16_t* T1; bf16_t* Gb;
    __device__ __forceinline__ void operator()(int row, int col, f32x4 v) const { const size_t off = (size_t)row * DM + col; *(u32x2*)(Gb + off) = pack4(unpack4(*(const u32x2*)(T1 + off)) + unpack4(*(const u32x2*)(Gb + off)) * v); } };
struct SPleGate { const bf16_t* E; bf16_t* O;
    __device__ __forceinline__ void operator()(int row, int col, f32x4 v) const { const size_t off = (size_t)row * DM + col; const f32x4 e = unpack4(*(const u32x2*)(E + off)); f32x4 o;
#pragma unroll
        for (int j = 0; j < 4; ++j) o[j] = sigm(v[j]) * e[j];
        *(u32x2*)(O + off) = pack4(o); } };
template <class Epi> __device__ __forceinline__ void sgemm_sample(LAS unsigned char* lds, const bf16_t* A, const bf16_t* Bt, int N, int K, const Epi& E, int bx, int G, int wave, int lane) {
    const int fr = lane & 15, fq = lane >> 4, nblk = N >> 2, per = K >> 8;
    LAS f32x4* slots = (LAS f32x4*)lds;
    for (int bt = bx; bt < nblk; bt += G) {
        const int rb = bt & 7, cb = bt >> 3;
        const bf16_t* ap = A + (size_t)(MP + 32 * rb + fr) * K + 32 * (wave * per) + 8 * fq;
        const bf16_t* bp = Bt + (size_t)(32 * cb + fr) * K + 32 * (wave * per) + 8 * fq;
        const size_t r16 = (size_t)16 * K;
        f32x4 acc00 = zero_acc(), acc01 = zero_acc(), acc10 = zero_acc(), acc11 = zero_acc();
        for (int s0 = 0; s0 < per; s0 += 4) {
            bf16x8 a0[4], a1[4], b0[4], b1[4];
#pragma unroll
            for (int u = 0; u < 4; ++u) { const int su = (s0 + u < per) ? s0 + u : per - 1;
                a0[u] = *(const bf16x8*)(ap + 32 * su); a1[u] = *(const bf16x8*)(ap + r16 + 32 * su); b0[u] = *(const bf16x8*)(bp + 32 * su); b1[u] = *(const bf16x8*)(bp + r16 + 32 * su); }
#pragma unroll
            for (int u = 0; u < 4; ++u) { if (s0 + u < per) {
                acc00 = __builtin_amdgcn_mfma_f32_16x16x32_bf16(b0[u], a0[u], acc00, 0, 0, 0); acc01 = __builtin_amdgcn_mfma_f32_16x16x32_bf16(b1[u], a0[u], acc01, 0, 0, 0);
                acc10 = __builtin_amdgcn_mfma_f32_16x16x32_bf16(b0[u], a1[u], acc10, 0, 0, 0); acc11 = __builtin_amdgcn_mfma_f32_16x16x32_bf16(b1[u], a1[u], acc11, 0, 0, 0); } }
        }
        __syncthreads();
        slots[(wave * 4 + 0) * 64 + lane] = acc00; slots[(wave * 4 + 1) * 64 + lane] = acc01; slots[(wave * 4 + 2) * 64 + lane] = acc10; slots[(wave * 4 + 3) * 64 + lane] = acc11;
        __syncthreads();
        if (wave < 4) {
            f32x4 sum = slots[(0 * 4 + wave) * 64 + lane];
#pragma unroll
            for (int w = 1; w < 8; ++w) sum = sum + slots[(w * 4 + wave) * 64 + lane];
            const int i = wave >> 1, j = wave & 1;
            E(MP + 32 * rb + 16 * i + fr, 32 * cb + 16 * j + 4 * fq, sum);
        }
    }
    __syncthreads();
}

__device__ __forceinline__ unsigned pk2(float lo, float hi) { return cvt_pk_bf16(lo, hi); }
__device__ __forceinline__ void transpose_item(const float* W, int ldn, int src_n0, int K, bf16_t* WT, int dst_n0, int k0, LAS float* scr, int lane) {
    const int nq = (lane & 7) * 4, kr = lane >> 3;
    f32x4 v[8];
#pragma unroll
    for (int i = 0; i < 8; ++i) v[i] = __builtin_nontemporal_load((const f32x4*)(W + (size_t)(k0 + 8 * i + kr) * ldn + src_n0 + nq));
#pragma unroll
    for (int i = 0; i < 8; ++i) { LAS float* d = scr + (8 * i + kr) * 33 + nq; d[0] = v[i].x; d[1] = v[i].y; d[2] = v[i].z; d[3] = v[i].w; }
    asm volatile("s_waitcnt lgkmcnt(0)" ::: "memory");
    const int c = lane & 7;
#pragma unroll
    for (int j = 0; j < 4; ++j) { const int n = (lane >> 3) + 8 * j; const LAS float* s = scr + (8 * c) * 33 + n;
        u32x4 o; o.x = pk2(s[0 * 33], s[1 * 33]); o.y = pk2(s[2 * 33], s[3 * 33]); o.z = pk2(s[4 * 33], s[5 * 33]); o.w = pk2(s[6 * 33], s[7 * 33]);
        *(u32x4*)(WT + (size_t)(dst_n0 + n) * K + k0 + 8 * c) = o; }
    asm volatile("s_waitcnt lgkmcnt(0)" ::: "memory");
}
__device__ __forceinline__ int map_gu(int n) { const int pn = n >> 8, bj = (n >> 7) & 1, jj = n & 127; return bj * DFF + pn * 128 + jj; }
__device__ __forceinline__ int map_in(int n) {
    if (n < 2048) { const int h = n >> 8, bj = (n >> 7) & 1, kk = n & 127; return bj * 1024 + h * 128 + kk; }
    if (n < 3072) return n;
    if (n < 3584) return 4096 + (n - 3072);
    if (n < 4608) return 3072 + (n - 3584);
    return n;
}
__device__ __forceinline__ void rms_row_to_bf16(const float* xrow, const float* g, bf16_t* orow, int lane) {
    const f32x4* xr = (const f32x4*)xrow + lane; f32x4 v[4]; float s = 0.f;
#pragma unroll
    for (int j = 0; j < 4; ++j) { v[j] = __builtin_nontemporal_load(xr + 64 * j); s += (v[j].x * v[j].x + v[j].y * v[j].y) + (v[j].z * v[j].z + v[j].w * v[j].w); }
    const float r = rsqrtf(wave_sum(s) * (1.f / 1024.f) + EPS);
    u32x2* o8 = (u32x2*)orow + lane;
#pragma unroll
    for (int j = 0; j < 4; ++j) { const f32x4 gg = ((const f32x4*)g)[lane + 64 * j]; u32x2 w; w.x = pk2(v[j].x * r * gg.x, v[j].y * r * gg.y); w.y = pk2(v[j].z * r * gg.z, v[j].w * r * gg.w); o8[64 * j] = w; }
}
template <bool HAS_H> __device__ __forceinline__ void row_phase(const bf16_t* Y, const float* xin_p, const float* xin_s, float* xout, bf16_t* H, const float* g_post, float coef, const float* g_pre, int gw, int NGW, int lane) {
    for (int m = gw; m < M; m += NGW) {
        const float* xi = (m < MP) ? xin_p + (size_t)m * DM : xin_s + (size_t)(m - MP) * DM;
        const u32x2* yr = (const u32x2*)(Y + (size_t)m * DM) + lane; f32x4 y[4], x[4]; float s = 0.f;
#pragma unroll
        for (int j = 0; j < 4; ++j) { const u32x2 w = __builtin_nontemporal_load(yr + 64 * j); y[j] = (f32x4){bflo(w.x), bfhi(w.x), bflo(w.y), bfhi(w.y)}; x[j] = __builtin_nontemporal_load((const f32x4*)xi + lane + 64 * j);
            s += (y[j].x * y[j].x + y[j].y * y[j].y) + (y[j].z * y[j].z + y[j].w * y[j].w); }
        const float r = rsqrtf(wave_sum(s) * (1.f / 1024.f) + EPS) * coef; float s2 = 0.f;
#pragma unroll
        for (int j = 0; j < 4; ++j) { const f32x4 gg = ((const f32x4*)g_post)[lane + 64 * j]; x[j] = x[j] + y[j] * gg * r; __builtin_nontemporal_store(x[j], (f32x4*)(xout + (size_t)m * DM) + lane + 64 * j);
            s2 += (x[j].x * x[j].x + x[j].y * x[j].y) + (x[j].z * x[j].z + x[j].w * x[j].w); }
        if (HAS_H) {
            const float r2 = rsqrtf(wave_sum(s2) * (1.f / 1024.f) + EPS); u32x2* o8 = (u32x2*)(H + (size_t)m * DM) + lane;
#pragma unroll
            for (int j = 0; j < 4; ++j) { const f32x4 gg = ((const f32x4*)g_pre)[lane + 64 * j]; u32x2 w; w.x = pk2(x[j].x * r2 * gg.x, x[j].y * r2 * gg.y); w.y = pk2(x[j].z * r2 * gg.z, x[j].w * r2 * gg.w); o8[64 * j] = w; }
        }
    }
}

constexpr int HP = 136, L_QKBUF = 2 * 64 * HP * 2, L_KOFF = 64 * HP * 2, L_VT = 2 * L_QKBUF, L_VTSZ = 16 * 72 * 2, L_AL = L_VT + 2 * L_VTSZ, L_ALSZ = 64 * 72 * 2, L_ST = L_AL + 2 * L_ALSZ, L_STSZ = 16 * HP * 2;
static_assert(L_ST + 2 * L_STSZ <= 131072, "hgrn lds");
#define HG_LOAD2(c, RQ, RK, RV, EGN) do { _Pragma("unroll") for (int j_ = 0; j_ < 2; ++j_) { const int row_ = prow0 + 32 * j_, rowc_ = row_ < T ? row_ : T - 1; const size_t go_ = (size_t)(row0 + (c) * 64 + rowc_) * DM + qcol + pch * 8; \
            RQ[j_] = *(const u32x4*)(Qp + go_); RK[j_] = *(const u32x4*)(Kp + go_); } \
            { const int vrc_ = vrow < T ? vrow : T - 1; RV = *(const u32x4*)(Vb + (size_t)(row0 + (c) * 64 + vrc_) * DM + vcol + vhalf * 8); } \
            EGN = *(const f32x4*)(EG + (size_t)(cid0 + (c)) * 1024 + h * 128 + 16 * wave + 4 * fq); } while (0)
#define HG_WRITE2(bf, RQ, RK, RV) do { LAS unsigned char* qb_ = lds + (bf) * L_QKBUF; _Pragma("unroll") for (int j_ = 0; j_ < 2; ++j_) { const int row_ = prow0 + 32 * j_; const bool z_ = row_ >= T; \
            u32x4 q_ = RQ[j_], k_ = RK[j_]; if (z_) { q_ = (u32x4){0u, 0u, 0u, 0u}; k_ = q_; } \
            *(LAS u32x4*)(qb_ + (row_ * HP + pch * 8) * 2) = q_; *(LAS u32x4*)(qb_ + L_KOFF + (row_ * HP + pch * 8) * 2) = k_; } \
            if (tid < 128) { u32x4 v_ = RV; if (vrow >= T) v_ = (u32x4){0u, 0u, 0u, 0u}; LAS unsigned short* vt_ = (LAS unsigned short*)(lds + L_VT + (bf) * L_VTSZ) + (vhalf * 8) * 72 + vrow; \
                vt_[0 * 72] = (unsigned short)v_.x; vt_[1 * 72] = (unsigned short)(v_.x >> 16); vt_[2 * 72] = (unsigned short)v_.y; vt_[3 * 72] = (unsigned short)(v_.y >> 16); \
                vt_[4 * 72] = (unsigned short)v_.z; vt_[5 * 72] = (unsigned short)(v_.z >> 16); vt_[6 * 72] = (unsigned short)v_.w; vt_[7 * 72] = (unsigned short)(v_.w >> 16); } } while (0)
#define HG_STEP(cc) do { const int c_ = (cc); const int bf = c_ & 1; \
            if (wave < 4) __builtin_amdgcn_s_setprio(2);   \
            if (wave < 4 && c_ > 0) { \
                const LAS unsigned char* ALp = lds + L_AL + (bf ^ 1) * L_ALSZ; \
                const int tt = wave, nks = (tt >> 1) + 1; \
                { const bf16x8 af = *(const LAS bf16x8*)(ALp + ((16 * tt + fr) * 72 + 8 * fq) * 2); oprev = __builtin_amdgcn_mfma_f32_16x16x32_bf16(vprev0, af, oprev, 0, 0, 0); } \
                if (nks > 1) { const bf16x8 af = *(const LAS bf16x8*)(ALp + ((16 * tt + fr) * 72 + 32 + 8 * fq) * 2); oprev = __builtin_amdgcn_mfma_f32_16x16x32_bf16(vprev1, af, oprev, 0, 0, 0); } \
                const int t = 16 * tt + fr; \
                if (t < T) { const size_t grow = (size_t)(row0 + (c_ - 1) * 64 + t); u32x2 w; w.x = pk2(oprev[0], oprev[1]); w.y = pk2(oprev[2], oprev[3]); *(u32x2*)(Ob + grow * DM + vcol + 4 * fq) = w; } \
            } \
            if (c_ < nch) { \
            const LAS unsigned char* QL = lds + bf * L_QKBUF; const LAS unsigned char* KL = QL + L_KOFF; const LAS unsigned char* VT = lds + L_VT + bf * L_VTSZ; \
            const LAS unsigned char* STo = lds + L_ST + bf * L_STSZ; LAS unsigned char* STn = lds + L_ST + (bf ^ 1) * L_STSZ; LAS unsigned char* AL = lds + L_AL + bf * L_ALSZ; \
            f32x4 oacc = zero_acc(); \
            if (wave < 4) { \
                const int tt = wave; bf16x8 qf[4]; \
_Pragma("unroll") \
                for (int ks = 0; ks < 4; ++ks) qf[ks] = *(const LAS bf16x8*)(QL + ((16 * tt + fr) * HP + 32 * ks + 8 * fq) * 2); \
                f32x4 a = zero_acc(); \
_Pragma("unroll") \
                for (int ks = 0; ks < 4; ++ks) { const bf16x8 kf = *(const LAS bf16x8*)(KL + ((16 * tt + fr) * HP + 32 * ks + 8 * fq) * 2); a = __builtin_amdgcn_mfma_f32_16x16x32_bf16(kf, qf[ks], a, 0, 0, 0); } \
_Pragma("unroll") \
                for (int i = 0; i < 4; ++i) if (4 * fq + i > fr) a[i] = 0.f; \
                { u32x2 w; w.x = pk2(a[0], a[1]); w.y = pk2(a[2], a[3]); *(LAS u32x2*)(AL + ((16 * tt + fr) * 72 + 16 * tt + 4 * fq) * 2) = w; } \
_Pragma("unroll") \
                for (int ks = 0; ks < 4; ++ks) { const bf16x8 sf = *(const LAS bf16x8*)(STo + (fr * HP + 32 * ks + 8 * fq) * 2); oacc = __builtin_amdgcn_mfma_f32_16x16x32_bf16(sf, qf[ks], oacc, 0, 0, 0); } \
            } else { \
                if (wave == 4) { bf16x8 kf[4];   \
_Pragma("unroll") \
                    for (int ks = 0; ks < 4; ++ks) kf[ks] = *(const LAS bf16x8*)(KL + (fr * HP + 32 * ks + 8 * fq) * 2); \
_Pragma("unroll") \
                    for (int tt = 1; tt < 3; ++tt) { f32x4 a = zero_acc(); \
_Pragma("unroll") \
                        for (int ks = 0; ks < 4; ++ks) { const bf16x8 qf = *(const LAS bf16x8*)(QL + ((16 * tt + fr) * HP + 32 * ks + 8 * fq) * 2); a = __builtin_amdgcn_mfma_f32_16x16x32_bf16(kf[ks], qf, a, 0, 0, 0); } \
                        u32x2 w; w.x = pk2(a[0], a[1]); w.y = pk2(a[2], a[3]); *(LAS u32x2*)(AL + ((16 * tt + fr) * 72 + 4 * fq) * 2) = w; } \
                } else if (wave == 5) { bf16x8 qf[4];   \
_Pragma("unroll") \
                    for (int ks = 0; ks < 4; ++ks) qf[ks] = *(const LAS bf16x8*)(QL + ((48 + fr) * HP + 32 * ks + 8 * fq) * 2); \
_Pragma("unroll") \
                    for (int st = 0; st < 2; ++st) { f32x4 a = zero_acc(); \
_Pragma("unroll") \
                        for (int ks = 0; ks < 4; ++ks) { const bf16x8 kf = *(const LAS bf16x8*)(KL + ((16 * st + fr) * HP + 32 * ks + 8 * fq) * 2); a = __builtin_amdgcn_mfma_f32_16x16x32_bf16(kf, qf[ks], a, 0, 0, 0); } \
                        u32x2 w; w.x = pk2(a[0], a[1]); w.y = pk2(a[2], a[3]); *(LAS u32x2*)(AL + ((48 + fr) * 72 + 16 * st + 4 * fq) * 2) = w; } \
                } else { const int tt = (wave == 6) ? 2 : 3, st = tt - 1;   \
                    f32x4 a = zero_acc(); \
_Pragma("unroll") \
                    for (int ks = 0; ks < 4; ++ks) { const bf16x8 kf = *(const LAS bf16x8*)(KL + ((16 * st + fr) * HP + 32 * ks + 8 * fq) * 2); const bf16x8 qf = *(const LAS bf16x8*)(QL + ((16 * tt + fr) * HP + 32 * ks + 8 * fq) * 2); \
                        a = __builtin_amdgcn_mfma_f32_16x16x32_bf16(kf, qf, a, 0, 0, 0); } \
                    u32x2 w; w.x = pk2(a[0], a[1]); w.y = pk2(a[2], a[3]); *(LAS u32x2*)(AL + ((16 * tt + fr) * 72 + 16 * st + 4 * fq) * 2) = w; \
                } \
            } \
            bf16x8 vf[2]; \
_Pragma("unroll") \
            for (int ks = 0; ks < 2; ++ks) vf[ks] = *(const LAS bf16x8*)(VT + (fr * 72 + 32 * ks + 8 * fq) * 2); \
            {   \
              const unsigned ka_ = (unsigned)(__UINTPTR_TYPE__)KL + (unsigned)((8 * fq + (fr >> 2)) * (HP * 2) + 32 * wave + 8 * (fr & 3)); \
              s16x4 k00, k01, k10, k11; \
              asm volatile("ds_read_b64_tr_b16 %0, %4\n\tds_read_b64_tr_b16 %1, %4 offset:%5\n\tds_read_b64_tr_b16 %2, %4 offset:%6\n\tds_read_b64_tr_b16 %3, %4 offset:%7\n\ts_waitcnt lgkmcnt(0)" \
                           : "=&v"(k00), "=&v"(k01), "=&v"(k10), "=&v"(k11) : "v"(ka_), "n"(4 * HP * 2), "n"(32 * HP * 2), "n"(36 * HP * 2) : "memory"); \
              const bf16x8 kt0 = __builtin_shufflevector(k00, k01, 0, 1, 2, 3, 4, 5, 6, 7), kt1 = __builtin_shufflevector(k10, k11, 0, 1, 2, 3, 4, 5, 6, 7); \
              S = __builtin_amdgcn_mfma_f32_16x16x32_bf16(kt0, vf[0], S, 0, 0, 0); S = __builtin_amdgcn_mfma_f32_16x16x32_bf16(kt1, vf[1], S, 0, 0, 0); } \
            { S = S * eg; \
              u32x2 w; w.x = pk2(S[0], S[1]); w.y = pk2(S[2], S[3]); *(LAS u32x2*)(STn + (fr * HP + 16 * wave + 4 * fq) * 2) = w; } \
            oprev = oacc; vprev0 = vf[0]; vprev1 = vf[1]; \
            } \
            __builtin_amdgcn_s_setprio(0); \
        } while (0)
__device__ __forceinline__ void hgrn_phase(LAS unsigned char* lds, const bf16_t* Qp, const bf16_t* Kp, const bf16_t* Vb, bf16_t* Ob, const float* EG, const float* state_in, float* out_hp, float* out_hs, int G, int bx, int tid) {
    const int wave = __builtin_amdgcn_readfirstlane(tid >> 6), lane = tid & 63, fr = lane & 15, fq = lane >> 4;
    for (int i = tid; i < 2 * 64 * 72 / 2; i += NTHR) ((LAS unsigned*)(lds + L_AL))[i] = 0u;
    for (int item = bx; item < 640; item += G) {
        int b, h, slice, row0, nch, T, cid0; const float* S0; float* Sout;
        if (item < 128) { const int seq = item & 15; slice = item >> 4; b = seq >> 3; h = seq & 7; row0 = b * SEQ; nch = SEQ / 64; T = 64; cid0 = b * (SEQ / 64); S0 = nullptr; Sout = out_hp + (size_t)(b * 8 + h) * 16384; }
        else { const int j = item - 128, seq = j & 63; slice = j >> 6; b = seq >> 3; h = seq & 7; row0 = MP + b * DSEQ; nch = 1; T = DSEQ; cid0 = 256 + b; S0 = state_in + (size_t)(b * 8 + h) * 16384; Sout = out_hs + (size_t)(b * 8 + h) * 16384; }
        const int qcol = h * 128, vcol = h * 128 + slice * 16;
        f32x4 S;
#pragma unroll
        for (int i = 0; i < 4; ++i) S[i] = S0 ? S0[(size_t)(16 * wave + 4 * fq + i) * 128 + slice * 16 + fr] : 0.f;
        __syncthreads();
        { u32x2 w; w.x = pk2(S[0], S[1]); w.y = pk2(S[2], S[3]); *(LAS u32x2*)(lds + L_ST + (fr * HP + 16 * wave + 4 * fq) * 2) = w; }
        u32x4 rq[2], rk[2], rv;
        const int prow0 = tid >> 4, pch = tid & 15;
#define HG_LOAD(c) do { _Pragma("unroll") for (int j_ = 0; j_ < 2; ++j_) { const int row_ = prow0 + 32 * j_, rowc_ = row_ < T ? row_ : T - 1; const size_t go_ = (size_t)(row0 + (c) * 64 + rowc_) * DM + qcol + pch * 8; \
            rq[j_] = *(const u32x4*)(Qp + go_); rk[j_] = *(const u32x4*)(Kp + go_); } \
            { const int vrc_ = vrow < T ? vrow : T - 1; rv = *(const u32x4*)(Vb + (size_t)(row0 + (c) * 64 + vrc_) * DM + vcol + vhalf * 8); } \
            egn = *(const f32x4*)(EG + (size_t)(cid0 + (c)) * 1024 + h * 128 + 16 * wave + 4 * fq); } while (0)
#define HG_WRITE(bf) do { LAS unsigned char* qb_ = lds + (bf) * L_QKBUF; _Pragma("unroll") for (int j_ = 0; j_ < 2; ++j_) { const int row_ = prow0 + 32 * j_; const bool z_ = row_ >= T; \
            u32x4 q_ = rq[j_], k_ = rk[j_]; if (z_) { q_ = (u32x4){0u, 0u, 0u, 0u}; k_ = q_; } \
            *(LAS u32x4*)(qb_ + (row_ * HP + pch * 8) * 2) = q_; *(LAS u32x4*)(qb_ + L_KOFF + (row_ * HP + pch * 8) * 2) = k_; } \
            if (tid < 128) { u32x4 v_ = rv; if (vrow >= T) v_ = (u32x4){0u, 0u, 0u, 0u}; LAS unsigned short* vt_ = (LAS unsigned short*)(lds + L_VT + (bf) * L_VTSZ) + (vhalf * 8) * 72 + vrow; \
                vt_[0 * 72] = (unsigned short)v_.x; vt_[1 * 72] = (unsigned short)(v_.x >> 16); vt_[2 * 72] = (unsigned short)v_.y; vt_[3 * 72] = (unsigned short)(v_.y >> 16); \
                vt_[4 * 72] = (unsigned short)v_.z; vt_[5 * 72] = (unsigned short)(v_.z >> 16); vt_[6 * 72] = (unsigned short)v_.w; vt_[7 * 72] = (unsigned short)(v_.w >> 16); } } while (0)
        f32x4 egn, eg;
        const int vrow = (tid & 127) >> 1, vhalf = tid & 1;
        u32x4 rqB[2], rkB[2], rvB; f32x4 egB;
#define CLAMPC(x) ((x) < nch ? (x) : nch - 1)
        HG_LOAD2(0, rq, rk, rv, egn); HG_WRITE2(0, rq, rk, rv); eg = egn;
        HG_LOAD2(CLAMPC(1), rq, rk, rv, egn);
        f32x4 oprev = zero_acc(); bf16x8 vprev0 = (bf16x8){0, 0, 0, 0, 0, 0, 0, 0}, vprev1 = vprev0;
        for (int c = 0; c <= nch; c += 2) {
            HG_LOAD2(CLAMPC(c + 2), rqB, rkB, rvB, egB);
            __syncthreads();
            HG_STEP(c);
            HG_WRITE2(1, rq, rk, rv); eg = egn;
            if (c + 1 > nch) break;
            HG_LOAD2(CLAMPC(c + 3), rq, rk, rv, egn);
            __syncthreads();
            HG_STEP(c + 1);
            HG_WRITE2(0, rqB, rkB, rvB); eg = egB;
        }
#undef CLAMPC
#pragma unroll
        for (int i = 0; i < 4; ++i) Sout[(size_t)(16 * wave + 4 * fq + i) * 128 + slice * 16 + fr] = S[i];
#undef HG_LOAD
#undef HG_WRITE
    }
}

__device__ __forceinline__ void prep_og(const bf16_t* Ob, bf16_t* OG, const float* gn, int gw, int NGW, int lane) {
    for (int m = gw; m < M; m += NGW) {
#pragma unroll
        for (int j = 0; j < 2; ++j) {
            const int col = lane * 8 + 512 * j;
            f32x4 o0, o1, g0, g1; unpack8(__builtin_nontemporal_load((const u32x4*)(Ob + (size_t)m * DM + col)), o0, o1); unpack8(__builtin_nontemporal_load((const u32x4*)(OG + (size_t)m * DM + col)), g0, g1);
            float ssq = (o0.x * o0.x + o0.y * o0.y) + (o0.z * o0.z + o0.w * o0.w) + (o1.x * o1.x + o1.y * o1.y) + (o1.z * o1.z + o1.w * o1.w);
            ssq += __shfl_xor(ssq, 1); ssq += __shfl_xor(ssq, 2); ssq += __shfl_xor(ssq, 4); ssq += __shfl_xor(ssq, 8);
            const float rs = rsqrtf(ssq * (1.f / 128.f) + EPS);
            const f32x4 n0 = *(const f32x4*)(gn + (col & 127)), n1 = *(const f32x4*)(gn + (col & 127) + 4);
            *(u32x4*)(OG + (size_t)m * DM + col) = pack8(o0 * n0 * g0 * rs, o1 * n1 * g1 * rs);
        }
    }
}
__device__ __forceinline__ void pool_row(const bf16_t* Ub, bf16_t* POOLED, const float* state_pool, float* out_pp, float* out_ps, int m, int lane) {
    int t, pos, TL; const float* buf; float* po;
    if (m < MP) { const int b = m / SEQ; t = m % SEQ; pos = t; TL = SEQ; buf = nullptr; po = out_pp + (size_t)b * 15 * 512; }
    else { const int b = (m - MP) / DSEQ; t = (m - MP) % DSEQ; pos = PAST + t; TL = DSEQ; buf = state_pool + (size_t)b * 15 * 512; po = out_ps + (size_t)b * 15 * 512; }
    const int col = lane * 8, w = 2 << (lane >> 4);
    f32x4 s0 = (f32x4){0.f, 0.f, 0.f, 0.f}, s1 = s0, u0 = s0, u1 = s0;
    for (int jj = 0; jj < w; ++jj) {
        const int tt = t - jj; f32x4 a0, a1;
        if (tt >= 0) unpack8(*(const u32x4*)(Ub + (size_t)(m - jj) * BW + col), a0, a1);
        else if (buf) { a0 = *(const f32x4*)(buf + (size_t)(15 + tt) * 512 + col); a1 = *(const f32x4*)(buf + (size_t)(15 + tt) * 512 + col + 4); }
        else { a0 = (f32x4){0.f, 0.f, 0.f, 0.f}; a1 = a0; }
        if (jj == 0) { u0 = a0; u1 = a1; }
        s0 = s0 + a0; s1 = s1 + a1;
    }
    const float ic = 1.0f / (float)((pos + 1 < w) ? pos + 1 : w);
    *(u32x4*)(POOLED + (size_t)m * BW + col) = pack8(s0 * ic - u0, s1 * ic - u1);
    if (t >= TL - 15) { float* p = po + (size_t)(t - (TL - 15)) * 512 + col; *(f32x4*)p = u0; *(f32x4*)(p + 4) = u1; }
}
__device__ __forceinline__ void prep_pool(const bf16_t* Ub, bf16_t* POOLED, const float* state_pool, float* out_pp, float* out_ps, int gw, int NGW, int lane) {
    const int col = lane * 8, w = 2 << (lane >> 4); const float ic = 1.0f / (float)w;
    for (int m0 = gw; m0 < M; m0 += 2 * NGW) {
        const int m1 = m0 + NGW; const bool two = m1 < M;
        const int t0 = (m0 < MP) ? m0 % SEQ : (m0 - MP) % DSEQ, t1 = two ? ((m1 < MP) ? m1 % SEQ : (m1 - MP) % DSEQ) : 0;
        if (two && t0 >= 15 && t1 >= 15) {
            u32x4 r0[16], r1[16];
#pragma unroll
            for (int jj = 0; jj < 16; ++jj) { r0[jj] = (u32x4){0u, 0u, 0u, 0u}; r1[jj] = r0[jj];
                if (jj < w) { r0[jj] = *(const u32x4*)(Ub + (size_t)(m0 - jj) * BW + col); r1[jj] = *(const u32x4*)(Ub + (size_t)(m1 - jj) * BW + col); } }
#pragma unroll
            for (int h = 0; h < 2; ++h) {
                const int m = h ? m1 : m0, t = h ? t1 : t0;
                f32x4 s0 = (f32x4){0.f, 0.f, 0.f, 0.f}, s1 = s0, u0 = s0, u1 = s0;
#pragma unroll
                for (int jj = 0; jj < 16; ++jj) { f32x4 a0, a1; unpack8(h ? r1[jj] : r0[jj], a0, a1); s0 = s0 + a0; s1 = s1 + a1; if (jj == 0) { u0 = a0; u1 = a1; } }
                *(u32x4*)(POOLED + (size_t)m * BW + col) = pack8(s0 * ic - u0, s1 * ic - u1);
                const int TL = (m < MP) ? SEQ : DSEQ;
                if (t >= TL - 15) { float* po = (m < MP) ? out_pp + (size_t)(m / SEQ) * 15 * 512 : out_ps + (size_t)((m - MP) / DSEQ) * 15 * 512;
                    float* p = po + (size_t)(t - (TL - 15)) * 512 + col; *(f32x4*)p = u0; *(f32x4*)(p + 4) = u1; }
            }
        } else { pool_row(Ub, POOLED, state_pool, out_pp, out_ps, m0, lane); if (two) pool_row(Ub, POOLED, state_pool, out_pp, out_ps, m1, lane); }
    }
}

typedef __attribute__((address_space(1))) unsigned gu32;
#define XB_TMO      128
#define XB_XCNT(j)  (256  + 64 * (j))
#define XB_XSUB(j)  (1280 + 64 * (j))
#define XB_XGEN(j)  (2304 + 64 * (j))
#define XB_TOP      3328
#define XB_TOPGEN   3392
#define XCD_BAR_WORDS 3456
#define XB_SPIN_CAP (1u << 18)

__device__ __forceinline__ unsigned xb_ld(unsigned* p)              { return __hip_atomic_load(p, __ATOMIC_RELAXED, __HIP_MEMORY_SCOPE_AGENT); }
__device__ __forceinline__ unsigned xb_add(unsigned* p, unsigned v) { return __hip_atomic_fetch_add(p, v, __ATOMIC_RELAXED, __HIP_MEMORY_SCOPE_AGENT); }
__device__ __forceinline__ unsigned xb_xcc_id() { return (unsigned)__builtin_amdgcn_s_getreg((3 << 11) | 20) & 0xFu; }
#define XB_SPIN(cond, bar) do { unsigned _sp = 0; while (cond) { __builtin_amdgcn_s_sleep(1); \
    if ((++_sp & 255u) == 0u) { if (xb_ld(&(bar)[XB_TMO])) break; if (_sp > XB_SPIN_CAP) { atomicAdd(&(bar)[XB_TMO], 1u); break; } } } } while (0)

struct XcdBarrier {
    unsigned* bar; unsigned x;
    volatile LAS unsigned* st;
};

__device__ __forceinline__ XcdBarrier xcd_barrier_post(unsigned* bar, volatile LAS unsigned* st) {
    XcdBarrier b; b.bar = bar; b.x = xb_xcc_id(); b.st = st;
    if (threadIdx.x == 0) (void)xb_add(&bar[XB_XCNT(b.x)], 1u);
    return b;
}
__device__ __forceinline__ void xcd_barrier_complete(unsigned* bar, unsigned x, unsigned& nloc, unsigned& nx) {
    const unsigned G = gridDim.x * gridDim.y * gridDim.z;
    unsigned sum, cnt, mine, sp = 0u;
    for (;;) {
        sum = 0u; cnt = 0u; mine = 0u;
#pragma unroll
        for (unsigned j = 0; j < 16; ++j) { const unsigned c = xb_ld(&bar[XB_XCNT(j)]); sum += c; cnt += (c > 0u) ? 1u : 0u; mine = (j == x) ? c : mine; }
        if (sum == G) break;
        __builtin_amdgcn_s_sleep(1);
        if ((++sp & 255u) == 0u) { if (xb_ld(&bar[XB_TMO])) break; if (sp > XB_SPIN_CAP) { atomicAdd(&bar[XB_TMO], 1u); break; } }
    }
    nloc = mine > 0u ? mine : 1u; nx = cnt > 0u ? cnt : 1u;
}

__device__ __forceinline__ void xcd_barrier(const XcdBarrier& b) {
    asm volatile("s_waitcnt vmcnt(0)" ::: "memory");
    __syncthreads();
    if (threadIdx.x == 0) {
        unsigned* bar = b.bar;
        __builtin_amdgcn_s_waitcnt(0);
        unsigned nloc = b.st[0], nx = b.st[1];
        if (nloc == 0u) { xcd_barrier_complete(bar, b.x, nloc, nx); b.st[0] = nloc; b.st[1] = nx; }
        const unsigned old = xb_add(&bar[XB_XSUB(b.x)], 1u);
        const unsigned gen = old / nloc;
        if (old + 1u == (gen + 1u) * nloc) {
            __builtin_amdgcn_fence(__ATOMIC_RELEASE, "agent");
            asm volatile("s_waitcnt vmcnt(0)" ::: "memory");
            const unsigned og = xb_add(&bar[XB_TOP], 1u);
            const unsigned tg = og / nx;
            if (og + 1u == (tg + 1u) * nx) xb_add(&bar[XB_TOPGEN], 1u);
            else XB_SPIN(xb_ld(&bar[XB_TOPGEN]) == tg, bar);
            __builtin_amdgcn_fence(__ATOMIC_ACQUIRE, "agent");
            xb_add(&bar[XB_XGEN(b.x)], 1u);
            asm volatile("s_waitcnt vmcnt(0)" ::: "memory");
        } else {
            XB_SPIN(xb_ld(&bar[XB_XGEN(b.x)]) == gen, bar);
            __builtin_amdgcn_fence(__ATOMIC_ACQUIRE, "agent");
            asm volatile("s_waitcnt vmcnt(0)" ::: "memory");
        }
    }
    __syncthreads();
}

struct Args { const float* in[21]; float* out; unsigned char* ws; };
enum { I_XP = 0, I_XS, I_PP, I_PS, I_SH, I_SP, I_GAINS, I_LB, I_GU1, I_D1, I_WIN, I_GN, I_WA, I_WPOOL, I_PSCALE, I_WB, I_WOUT, I_GU2, I_D2, I_WPP, I_WPG };

__global__ void __launch_bounds__(NTHR, 2) mega_fwd(Args a) {
    extern __shared__ __attribute__((aligned(16))) unsigned char lds_raw[];
    LAS unsigned char* lds = (LAS unsigned char*)lds_raw;
    cg::grid_group grid = cg::this_grid();
    const int tid = threadIdx.x, lane = tid & 63, wave = __builtin_amdgcn_readfirstlane(tid >> 6);
    const int G = gridDim.x, bx = blockIdx.x, vcu = (G % 8 == 0) ? (bx % 8) * (G / 8) + bx / 8 : bx;
    const int gw = vcu * NWAVES + wave, NGW = G * NWAVES;
    unsigned char* ws = a.ws; float* out = a.out;
    float* LB = (float*)(ws + WS_LB); float* EG = (float*)(ws + WS_EG);
    bf16_t* H = (bf16_t*)(ws + WS_H); bf16_t* Y = (bf16_t*)(ws + WS_Y); bf16_t* ACT = (bf16_t*)(ws + B_ACT);
    bf16_t *Qp = (bf16_t*)(ws + B_QP), *Kp = (bf16_t*)(ws + B_KP), *Vb = (bf16_t*)(ws + B_VB), *OG = (bf16_t*)(ws + B_OG), *Ob = (bf16_t*)(ws + B_O), *GA = (bf16_t*)(ws + B_GA), *GB = (bf16_t*)(ws + B_GB);
    bf16_t *Ub = (bf16_t*)(ws + WS_U), *POOLED = (bf16_t*)(ws + WS_POOLED), *PM = (bf16_t*)(ws + WS_PM), *Eb = (bf16_t*)(ws + B_E), *Pb = (bf16_t*)(ws + B_PB);
    const float* gains = a.in[I_GAINS];
    { volatile LAS unsigned* st0 = (volatile LAS unsigned*)(lds + 131072 + 256); if (tid < 2) st0[tid] = 0u; }
    __syncthreads();
    XcdBarrier xbar = xcd_barrier_post((unsigned*)(ws + WS_SS), (volatile LAS unsigned*)(lds + 131072 + 256));
    grid.sync();
#define GSYNC() xcd_barrier(xbar)
#define WT(off) ((bf16_t*)(ws + (off)))
    constexpr int NI_GU = 16 * 176, NI_D = 44 * 32, NI_IN = 16 * 208, NI_SQ = 16 * 32, NI_B = 8 * 32, NI_PP = 4 * 32;
    constexpr int NI_EARLY = NI_GU + NI_D + NI_IN, NITEMS = 2 * NI_GU + 2 * NI_D + NI_IN + 3 * NI_SQ + NI_B + NI_PP;
    constexpr int IT_D2 = NI_EARLY + NI_GU, IT_A = IT_D2 + NI_D, IT_PG = IT_A + 2 * NI_SQ, IT_B = IT_PG + NI_SQ, IT_PP = IT_B + NI_B;
#define CONVERT_ITEMS(lo_, hi_, gw_, ngw_) do { LAS float* scr_ = (LAS float*)(lds + wave * 16384); const int lane_ = otid() & 63; \
        for (int it = (lo_) + (gw_); it < (hi_); it += (ngw_)) { int r = it; const float* W; int K, N, kind = 0; bf16_t* dst; \
            if (r < NI_GU) { W = a.in[I_GU1]; K = 1024; N = 5632; dst = WT(W_GU1); kind = 1; } \
            else if ((r -= NI_GU) < NI_D) { W = a.in[I_D1]; K = 2816; N = 1024; dst = WT(W_D1); } \
            else if ((r -= NI_D) < NI_IN) { W = a.in[I_WIN]; K = 1024; N = 6656; dst = WT(W_IN); kind = 2; } \
            else if ((r -= NI_IN) < NI_GU) { W = a.in[I_GU2]; K = 1024; N = 5632; dst = WT(W_GU2); kind = 1; } \
            else if ((r -= NI_GU) < NI_D) { W = a.in[I_D2]; K = 2816; N = 1024; dst = WT(W_D2); } \
            else if ((r -= NI_D) < NI_SQ) { W = a.in[I_WA]; K = 1024; N = 1024; dst = WT(W_A); } \
            else if ((r -= NI_SQ) < NI_SQ) { W = a.in[I_WOUT]; K = 1024; N = 1024; dst = WT(W_OUT); } \
            else if ((r -= NI_SQ) < NI_SQ) { W = a.in[I_WPG]; K = 1024; N = 1024; dst = WT(W_PG); } \
            else if ((r -= NI_SQ) < NI_B) { W = a.in[I_WB]; K = 512; N = 1024; dst = WT(W_B); } \
            else { r -= NI_B; W = a.in[I_WPP]; K = 256; N = 1024; dst = WT(W_PP); } \
            const int nblk = N / 32, kb = r / nblk, nb = r % nblk, dn = nb * 32; \
            const int sn = kind == 1 ? map_gu(dn) : (kind == 2 ? map_in(dn) : dn); \
            transpose_item(W, N, sn, K, dst, dn, kb * 64, scr_, lane_); } } while (0)
#define SGW bx, G, wave, otid() & 63
#define GEMM(EpiT, E, Aptr, Btptr, N_, K_, nNp, pn0p, nNs, pn0s, rot) do { pg8::Gemm g_{(Aptr), (Btptr), M, (N_), (K_)}; TileSched S_; S_.init((nNp), (pn0p), (nNs), (pn0s), G, (bx + (rot)) % G); \
        pg8::gemm_phase<EpiT, TileSched, true, true>(lds, g_, S_, (E)); } while (0)

    {
        CONVERT_ITEMS(0, (G == 256) ? NI_GU : NI_EARLY, gw, NGW);
        const int gt = bx * NTHR + tid, NGT = G * NTHR;
        { const float* wp = a.in[I_WPOOL]; bf16_t* d = WT(W_POOL);
          for (int idx = gt; idx < 512 * 512 / 2; idx += NGT) { const int n = idx >> 8, k = (idx & 255) * 2, g1 = n >> 7, dd = n & 127, g2 = k >> 7, c = k & 127;
              float v0 = 0.f, v1 = 0.f; if (g1 == g2) { v0 = wp[(size_t)(g1 * 128 + c) * 128 + dd]; v1 = wp[(size_t)(g1 * 128 + c + 1) * 128 + dd]; }
              ((unsigned*)d)[idx] = pk2(v0, v1); } }
        for (int idx = gt; idx < 1024; idx += NGT) { const float l0 = a.in[I_LB][idx], l1 = a.in[I_LB][1024 + idx]; LB[idx] = 1.0f / (1.0f + __expf(l1 - l0)); }
        for (int m = gw; m < M; m += NGW) { const float* xr = (m < MP) ? a.in[I_XP] + (size_t)m * DM : a.in[I_XS] + (size_t)(m - MP) * DM; rms_row_to_bf16(xr, gains + 0 * DM, H + (size_t)m * DM, lane); }
    }
    GSYNC();
    { EpiSwiGLU E{ACT}; GEMM(EpiSwiGLU, E, H, WT(W_GU1), 5632, 1024, 22, 0, 22, 0, 0); }
    if (G == 256 && bx >= 150) {
        __syncthreads(); CONVERT_ITEMS(NI_GU, NI_EARLY, (bx - 150) * NWAVES + wave, 106 * NWAVES); }
    GSYNC();
    { EpiStore<false> E{Y, DM, nullptr}; GEMM(EpiStore<false>, E, ACT, WT(W_D1), 1024, DFF, 4, 0, 0, 0, 0); SStore ES{Y, DM, nullptr}; sgemm_sample(lds, ACT, WT(W_D1), 1024, DFF, ES, SGW);
    }
    GSYNC();
    row_phase<true>(Y, a.in[I_XP], a.in[I_XS], out + O_Y, H, gains + 1 * DM, 0.5f, gains + 2 * DM, gw, NGW, otid() & 63);
    GSYNC();
    { EpiIn E{ws, EG, LB}; GEMM(EpiIn, E, H, WT(W_IN), NIN, 1024, 14, 0, 26, 0, 0); }
    if (G == 256 && bx >= 154) {
        __syncthreads(); const int gw4 = (bx - 154) * NWAVES + wave;
        CONVERT_ITEMS(IT_A, IT_PG, gw4, 102 * NWAVES); CONVERT_ITEMS(IT_B, IT_PP, gw4, 102 * NWAVES);
        CONVERT_ITEMS(NI_EARLY, NI_EARLY + NI_GU, gw4, 102 * NWAVES); }
    GSYNC();
    hgrn_phase(lds, Qp, Kp, Vb, Ob, EG, a.in[I_SH], out + O_HP, out + O_HS, G, bx, otid());
    { const int half = (G >= 256) ? 128 : 0;
      if (bx >= half) { __syncthreads(); const int gw2 = (bx - half) * NWAVES + wave, ngw2 = (G - half) * NWAVES;
          if (G == 256) { CONVERT_ITEMS(IT_D2, IT_A, gw2, ngw2); CONVERT_ITEMS(IT_PG, IT_B, gw2, ngw2); CONVERT_ITEMS(IT_PP, NITEMS, gw2, ngw2); }
          else CONVERT_ITEMS(NI_EARLY, NITEMS, gw2, ngw2);
          prep_pool(Ub, POOLED, a.in[I_SP], out + O_PP, out + O_PS, gw2, ngw2, otid() & 63);
          asm volatile("s_waitcnt vmcnt(0)" ::: "memory"); __syncthreads();
          if (otid() == 0) { __builtin_amdgcn_fence(__ATOMIC_RELEASE, "agent"); asm volatile("s_waitcnt vmcnt(0)" ::: "memory");
              unsigned* cnt = (unsigned*)(ws + 14336); __hip_atomic_fetch_add(cnt, 1u, __ATOMIC_RELAXED, __HIP_MEMORY_SCOPE_AGENT);
              unsigned sp = 0; while (__hip_atomic_load(cnt, __ATOMIC_RELAXED, __HIP_MEMORY_SCOPE_AGENT) < (unsigned)(G - half)) { __builtin_amdgcn_s_sleep(2); if (++sp > (1u << 22)) break; }
              __builtin_amdgcn_fence(__ATOMIC_ACQUIRE, "agent"); asm volatile("s_waitcnt vmcnt(0)" ::: "memory"); }
          __syncthreads();
          { EpiStore<true> E{PM, BW, a.in[I_PSCALE]}; pg8::Gemm g_{POOLED, WT(W_POOL), M, 512, 512}; TileSched S_; S_.init(2, 0, 0, 0, G - half, bx - half);
            pg8::gemm_phase<EpiStore<true>, TileSched, true, true>(lds, g_, S_, E);
            SStore ES{PM, BW, a.in[I_PSCALE]}; sgemm_sample(lds, POOLED, WT(W_POOL), 512, 512, ES, bx - half, G - half, wave, otid() & 63); }
          __syncthreads();
          { EpiIn E{ws, EG, LB}; pg8::Gemm g_{H, WT(W_IN), M, NIN, 1024}; TileSched S_; S_.init(4, 14, 0, 0, G - half, bx - half);
            pg8::gemm_phase<EpiIn, TileSched, true, true>(lds, g_, S_, E); } } }
    GSYNC();
    if (bx & 1) prep_og(Ob, OG, a.in[I_GN], gw, NGW, otid() & 63);
    { EpiIn E{ws, EG, LB}; GEMM(EpiIn, E, H, WT(W_IN), NIN, 1024, 8, 18, 0, 0, 0); }
    if (!(bx & 1)) prep_og(Ob, OG, a.in[I_GN], gw, NGW, otid() & 63);
    GSYNC();
    {
        { EpiMulInPlace E{GA}; GEMM(EpiMulInPlace, E, OG, WT(W_A), 1024, 1024, 4, 0, 0, 0, 0); SMulInPlace ES{GA}; sgemm_sample(lds, OG, WT(W_A), 1024, 1024, ES, SGW); }
        { EpiFmaInPlace E{GA, GB}; GEMM(EpiFmaInPlace, E, PM, WT(W_B), 1024, 512, 4, 0, 0, 0, 0); SFmaInPlace ES{GA, GB}; sgemm_sample(lds, PM, WT(W_B), 1024, 512, ES, SGW); }
    }
    GSYNC();
    { EpiStore<false> E{Y, DM, nullptr};
      GEMM(EpiStore<false>, E, GB, WT(W_OUT), 1024, 1024, 4, 0, 0, 0, 0); { SStore ES{Y, DM, nullptr}; sgemm_sample(lds, GB, WT(W_OUT), 1024, 1024, ES, SGW); }
    }
    GSYNC();
    row_phase<true>(Y, out + O_Y, out + O_Y + (size_t)MP * DM, out + O_Y, H, gains + 3 * DM, 1.0f, gains + 4 * DM, gw, NGW, otid() & 63);
    GSYNC();
    { EpiSwiGLU E{ACT}; GEMM(EpiSwiGLU, E, H, WT(W_GU2), 5632, 1024, 22, 0, 22, 0, 0); }
    { const int first = (G == 256) ? 150 : 0;
      if (bx >= first) { const int gt = (bx - first) * NTHR + otid(), NGT = (G - first) * NTHR;
        for (int idx = gt; idx < M * PLE / 4; idx += NGT) { const int e = idx * 4; const float* src = (e < MP * PLE) ? a.in[I_PP] + e : a.in[I_PS] + (e - MP * PLE); const f32x4 v = __builtin_nontemporal_load((const f32x4*)src);
            u32x2 w; w.x = pk2(v.x, v.y); w.y = pk2(v.z, v.w); ((u32x2*)Pb)[idx] = w; } } }
    GSYNC();
    { EpiStore<false> E{Y, DM, nullptr}; GEMM(EpiStore<false>, E, ACT, WT(W_D2), 1024, DFF, 4, 0, 0, 0, 0); SStore ES{Y, DM, nullptr}; sgemm_sample(lds, ACT, WT(W_D2), 1024, DFF, ES, SGW); }
    GSYNC();
    row_phase<true>(Y, out + O_Y, out + O_Y + (size_t)MP * DM, out + O_Y, H, gains + 5 * DM, 0.5f, gains + 6 * DM, gw, NGW, otid() & 63);
    GSYNC();
    { EpiStore<false> E{Eb, DM, nullptr}; GEMM(EpiStore<false>, E, Pb, WT(W_PP), 1024, PLE, 4, 0, 0, 0, 0); SStore ES{Eb, DM, nullptr}; sgemm_sample(lds, Pb, WT(W_PP), 1024, PLE, ES, SGW); }
    { EpiPleGate E{Eb, Y}; GEMM(EpiPleGate, E, H, WT(W_PG), 1024, 1024, 4, 0, 0, 0, 0); SPleGate ES{Eb, Y}; sgemm_sample(lds, H, WT(W_PG), 1024, 1024, ES, SGW); }
    GSYNC();
    row_phase<false>(Y, out + O_Y, out + O_Y + (size_t)MP * DM, out + O_Y, nullptr, gains + 7 * DM, 1.0f, nullptr, gw, NGW, otid() & 63);
#undef WT
#undef GEMM
}

extern "C" void kernel_launch(void* const* d_in, const int* in_sizes, int n_in, void* d_out, int out_size, void* d_ws, size_t ws_size, hipStream_t stream) {
    static int grid = 0;
    if (grid == 0) {
        if (n_in != 21 || in_sizes[0] != MP * DM || ws_size < WS_NEED) { fprintf(stderr, "kernel_launch: unexpected shapes (n_in %d, ws %zu, need %zu)\n", n_in, ws_size, (size_t)WS_NEED); grid = -1; return; }
        int dev = 0, cus = 0, per_cu = 0;
        hipGetDevice(&dev); hipDeviceGetAttribute(&cus, hipDeviceAttributeMultiprocessorCount, dev);
        hipFuncSetAttribute((const void*)mega_fwd, hipFuncAttributeMaxDynamicSharedMemorySize, LDS_BYTES);
        hipOccupancyMaxActiveBlocksPerMultiprocessor(&per_cu, (const void*)mega_fwd, NTHR, LDS_BYTES);
        if (per_cu < 1) { fprintf(stderr, "kernel_launch: occupancy query says %d blocks/CU\n", per_cu); per_cu = 1; }
        grid = cus;
        if (grid > 256) grid = 256;
        grid &= ~7;
    }
    if (grid <= 0) return;
    Args a{};
    for (int i = 0; i < 21; ++i) a.in[i] = (const float*)d_in[i];
    a.out = (float*)d_out; a.ws = (unsigned char*)d_ws;
    if (hipMemsetAsync(d_ws, 0, 16384, stream) != hipSuccess) { fprintf(stderr, "kernel_launch: memset failed\n"); return; }
    void* args[] = {&a};
    hipError_t e = hipLaunchCooperativeKernel((const void*)mega_fwd, dim3(grid), dim3(NTHR), args, LDS_BYTES, stream);
    if (e != hipSuccess) fprintf(stderr, "kernel_launch: cooperative launch failed: %s (grid %d)\n", hipGetErrorString(e), grid);
}
```
